# Optimizing an MI355X kernel written in HIP

```python
import math
import jax, jax.numpy as jnp
from jax import lax
import numpy as np

D_MODEL = 1024
BATCH = 8
SEQ = 8192
DEPTH = 2
DEC_BATCH = 8
DEC_SEQ = 4096
PAST_LEN = 128

GRID_W = 64
QBLK = 128
HEAD_DIM = 64
A_HEADS = 4
A_V_DIM = 2 * HEAD_DIM
B_Q_HEADS = 8
B_KV_HEADS = 2
B_GROUP = B_Q_HEADS // B_KV_HEADS
A_WIDTH = A_HEADS * A_V_DIM
B_WIDTH = B_Q_HEADS * HEAD_DIM
N_BRANCH = 2
D_FF = 4 * D_MODEL
N_BUCKETS = 32
MAX_DISTANCE = 128
ROPE_THETA = 10000.0
AXIS_DIM = HEAD_DIM // 2
EPS = 1e-6
SUBLN_EPS = 1e-5

QA_COLS = A_HEADS * 2 * HEAD_DIM
KA_COLS = A_HEADS * 2 * HEAD_DIM
VA_COLS = A_HEADS * A_V_DIM
QB_COLS = B_Q_HEADS * HEAD_DIM
KB_COLS = B_KV_HEADS * HEAD_DIM
VB_COLS = B_KV_HEADS * HEAD_DIM
GATE_COLS = N_BRANCH * D_MODEL
IN_COLS = QA_COLS + KA_COLS + VA_COLS + QB_COLS + KB_COLS + VB_COLS + GATE_COLS
SPLIT_1 = QA_COLS
SPLIT_2 = SPLIT_1 + KA_COLS
SPLIT_3 = SPLIT_2 + VA_COLS
SPLIT_4 = SPLIT_3 + QB_COLS
SPLIT_5 = SPLIT_4 + KB_COLS
SPLIT_6 = SPLIT_5 + VB_COLS

kernel_name = "hybrid_diffattn_gqa_axial_encoder"


def rmsnorm(x, g, eps=EPS):
    xf = x.astype(jnp.float32)
    y = xf * lax.rsqrt(jnp.mean(xf * xf, axis=-1, keepdims=True) + eps)
    return (y * g.astype(jnp.float32)).astype(x.dtype)


def t5_bucket(rel):
    nb = N_BUCKETS // 2
    max_exact = nb // 2
    ret = (rel > 0).astype(jnp.int32) * nb
    n = jnp.abs(rel)
    nf = jnp.maximum(n, 1).astype(jnp.float32)
    large = max_exact + (jnp.log(nf / max_exact) / math.log(MAX_DISTANCE / max_exact) * (nb - max_exact)).astype(jnp.int32)
    large = jnp.minimum(large, nb - 1)
    return ret + jnp.where(n < max_exact, n, large)


def axial_rope_tables(n):
    rows = n // GRID_W
    row = jnp.repeat(jnp.arange(rows, dtype=jnp.int32), GRID_W).astype(jnp.float32)
    col = jnp.tile(jnp.arange(GRID_W, dtype=jnp.int32), rows).astype(jnp.float32)
    inv = ROPE_THETA ** (-jnp.arange(0, AXIS_DIM, 2, dtype=jnp.float32) / AXIS_DIM)
    ang_r = row[:, None] * inv[None, :]
    ang_c = col[:, None] * inv[None, :]
    return (jnp.cos(ang_r), jnp.sin(ang_r), jnp.cos(ang_c), jnp.sin(ang_c))


def rope_rotate(x, cos, sin):
    half = x.shape[-1] // 2
    x1, x2 = x[..., :half], x[..., half:]
    return jnp.concatenate([x1 * cos - x2 * sin, x2 * cos + x1 * sin], axis=-1)


def axial_rope(x, tabs):
    cos_r, sin_r, cos_c, sin_c = tabs
    shp = (x.shape[1],) + (1,) * (x.ndim - 3) + (cos_r.shape[-1],)
    c = lambda t: t.reshape(shp).astype(x.dtype)
    xr = rope_rotate(x[..., :AXIS_DIM], c(cos_r), c(sin_r))
    xc = rope_rotate(x[..., AXIS_DIM:], c(cos_c), c(sin_c))
    return jnp.concatenate([xr, xc], axis=-1)


def diff_attention(qa, ka, va, t5_table, lam, subln_g, lam_init):
    B, N = qa.shape[0], qa.shape[1]
    nb = N // QBLK
    scale = HEAD_DIM ** -0.5
    qblocks = jnp.moveaxis(qa.reshape(B, nb, QBLK, A_HEADS, 2, HEAD_DIM), 1, 0)
    kpos = jnp.arange(N, dtype=jnp.int32)

    def one(args):
        q, i = args
        qpos = i * QBLK + jnp.arange(QBLK, dtype=jnp.int32)
        bias = t5_table[t5_bucket(kpos[None, :] - qpos[:, None])]
        bias = jnp.transpose(bias, (2, 0, 1)).astype(jnp.float32)
        s = jnp.einsum('bqhcd,bkhcd->bhcqk', q, ka).astype(jnp.float32) * scale + bias[None, :, None]
        p = jax.nn.softmax(s, axis=-1)
        w = p[:, :, 0] - lam * p[:, :, 1]
        return jnp.einsum('bhqk,bkhe->bqhe', w.astype(va.dtype), va)

    o = lax.map(one, (qblocks, jnp.arange(nb, dtype=jnp.int32)))
    o = jnp.moveaxis(o, 0, 1).reshape(B, N, A_HEADS, A_V_DIM)
    o = rmsnorm(o, subln_g, SUBLN_EPS) * (1.0 - lam_init)
    return o.reshape(B, N, A_WIDTH)


def gqa_attention(qb, kb, vb):
    B, N = qb.shape[0], qb.shape[1]
    nb = N // QBLK
    scale = HEAD_DIM ** -0.5
    qblocks = jnp.moveaxis(qb.reshape(B, nb, QBLK, B_KV_HEADS, B_GROUP, HEAD_DIM), 1, 0)

    def one(q):
        s = jnp.einsum('bqkgd,bnkd->bkgqn', q, kb).astype(jnp.float32) * scale
        p = jax.nn.softmax(s, axis=-1)
        return jnp.einsum('bkgqn,bnkd->bqkgd', p.astype(vb.dtype), vb)

    o = lax.map(one, qblocks)
    return jnp.moveaxis(o, 0, 1).reshape(B, N, B_WIDTH)


def encoder(x, t5_table, norm1, w_in, b_gate, lam_q1, lam_k1, lam_q2, lam_k2, subln_g,
            qk_norm_q, qk_norm_k, w_up_a, w_up_b, w_o, norm2, w_ff1, w_ff2, norm_f):
    B, N, _ = x.shape
    tabs = axial_rope_tables(N)
    for l in range(DEPTH):
        lam_init = 0.8 - 0.6 * math.exp(-0.3 * l)
        h = rmsnorm(x, norm1[l])
        z = h @ w_in[l]
        qa, ka, va, qb, kb, vb, zg = jnp.split(z, [SPLIT_1, SPLIT_2, SPLIT_3, SPLIT_4, SPLIT_5, SPLIT_6], axis=-1)
        lam = (jnp.exp(jnp.sum(lam_q1[l].astype(jnp.float32) * lam_k1[l].astype(jnp.float32)))
               - jnp.exp(jnp.sum(lam_q2[l].astype(jnp.float32) * lam_k2[l].astype(jnp.float32))) + lam_init)
        oa = diff_attention(qa.reshape(B, N, A_HEADS, 2, HEAD_DIM), ka.reshape(B, N, A_HEADS, 2, HEAD_DIM),
                            va.reshape(B, N, A_HEADS, A_V_DIM), t5_table, lam, subln_g[l], lam_init)
        qb = axial_rope(rmsnorm(qb.reshape(B, N, B_KV_HEADS, B_GROUP, HEAD_DIM), qk_norm_q[l]), tabs)
        kb = axial_rope(rmsnorm(kb.reshape(B, N, B_KV_HEADS, HEAD_DIM), qk_norm_k[l]), tabs)
        ob = gqa_attention(qb, kb, vb.reshape(B, N, B_KV_HEADS, HEAD_DIM))
        gates = jax.nn.sigmoid((zg + b_gate[l]).astype(jnp.float32)).astype(x.dtype)
        g_a, g_b = jnp.split(gates, 2, axis=-1)
        u = g_a * (oa @ w_up_a[l]) + g_b * (ob @ w_up_b[l])
        x = x + u @ w_o[l]
        h2 = rmsnorm(x, norm2[l])
        x = x + jnp.square(jax.nn.relu(h2 @ w_ff1[l])) @ w_ff2[l]
    return rmsnorm(x, norm_f)


def setup_inputs(seed: int = 0) -> dict:
    key = jax.random.key(seed)
    ks = jax.random.split(key, 24)
    f32 = jnp.float32
    nrm = lambda k, shape, s: jax.random.normal(k, shape, f32) * s
    gain = lambda k, shape: 1.0 + 0.02 * jax.random.normal(k, shape, f32)
    return {
        "x_prompt": jax.random.normal(ks[0], (BATCH, SEQ, D_MODEL), f32),
        "x_sample": jax.random.normal(ks[1], (DEC_BATCH, DEC_SEQ, D_MODEL), f32),
        "t5_table": nrm(ks[2], (N_BUCKETS, A_HEADS), 0.5),
        "norm1": gain(ks[3], (DEPTH, D_MODEL)),
        "w_in": nrm(ks[4], (DEPTH, D_MODEL, IN_COLS), D_MODEL ** -0.5),
        "b_gate": nrm(ks[5], (DEPTH, GATE_COLS), 0.02),
        "lam_q1": nrm(ks[6], (DEPTH, HEAD_DIM), 0.1),
        "lam_k1": nrm(ks[7], (DEPTH, HEAD_DIM), 0.1),
        "lam_q2": nrm(ks[8], (DEPTH, HEAD_DIM), 0.1),
        "lam_k2": nrm(ks[9], (DEPTH, HEAD_DIM), 0.1),
        "subln_g": gain(ks[10], (DEPTH, A_V_DIM)),
        "qk_norm_q": gain(ks[11], (DEPTH, HEAD_DIM)),
        "qk_norm_k": gain(ks[12], (DEPTH, HEAD_DIM)),
        "w_up_a": nrm(ks[13], (DEPTH, A_WIDTH, D_MODEL), A_WIDTH ** -0.5),
        "w_up_b": nrm(ks[14], (DEPTH, B_WIDTH, D_MODEL), B_WIDTH ** -0.5),
        "w_o": nrm(ks[15], (DEPTH, D_MODEL, D_MODEL), D_MODEL ** -0.5),
        "norm2": gain(ks[16], (DEPTH, D_MODEL)),
        "w_ff1": nrm(ks[17], (DEPTH, D_MODEL, D_FF), D_MODEL ** -0.5),
        "w_ff2": nrm(ks[18], (DEPTH, D_FF, D_MODEL), D_FF ** -0.5),
        "norm_f": gain(ks[19], (D_MODEL,)),
    }


def reference(x_prompt, x_sample, t5_table, norm1, w_in, b_gate, lam_q1, lam_k1, lam_q2, lam_k2, subln_g,
              qk_norm_q, qk_norm_k, w_up_a, w_up_b, w_o, norm2, w_ff1, w_ff2, norm_f):
    y_prompt = encoder(x_prompt, t5_table, norm1, w_in, b_gate, lam_q1, lam_k1, lam_q2, lam_k2, subln_g,
                       qk_norm_q, qk_norm_k, w_up_a, w_up_b, w_o, norm2, w_ff1, w_ff2, norm_f)
    y_sample = encoder(x_sample, t5_table, norm1, w_in, b_gate, lam_q1, lam_k1, lam_q2, lam_k2, subln_g,
                       qk_norm_q, qk_norm_k, w_up_a, w_up_b, w_o, norm2, w_ff1, w_ff2, norm_f)
    return (y_prompt, y_sample)
```

```cpp
#include <hip/hip_runtime.h>
#include <hip/hip_cooperative_groups.h>
#include <cstdio>
#include <cstdint>
namespace cg = cooperative_groups;
namespace pg8 {
#define PG8_LAS __attribute__((address_space(3)))
typedef unsigned short bf16_t;
typedef short bf16x8 __attribute__((ext_vector_type(8)));
typedef float f32x4 __attribute__((ext_vector_type(4)));
typedef unsigned u32x4 __attribute__((ext_vector_type(4)));
constexpr int BM = 256, BK = 64, HALF = 128, HTB = HALF * BK * 2  , STAGE_BYTES = 8 * HTB, NXCD = 8, WGM = 8;

__host__ __device__ __forceinline__ int lds_byte(int r, int c) { const int st = (r >> 4) * 2 + (c >> 5), rr = r & 15, cc = c & 31, ob = rr * 64 + cc * 2; return st * 1024 + (ob ^ (((ob >> 9) & 1) << 5)); }
__host__ __device__ __forceinline__ void stage_rc(int b, int& R, int& C) { const int st = b / 1024, sb = b % 1024, swz = sb ^ (((sb >> 9) & 1) << 5); R = (st >> 1) * 16 + swz / 64; C = (st & 1) * 32 + (swz % 64) / 2; }
__host__ __device__ __forceinline__ int perm32(int rho) { const int n = rho >> 4, i = rho & 15; return 8 * (i >> 2) + 4 * n + (i & 3); }

struct Unit { int pm, pn; };
struct Gemm { const bf16_t* A; const bf16_t* Bt; int M, N, K, lda, ldb; };

struct StaticOrder {
    int nM, nN, nwg, G, c;
    __host__ __device__ void init(int M, int N, int G_, int c_) { nM = M / BM; nN = N / BM; nwg = nM * nN; G = G_; c = c_; }
    __host__ __device__ bool next(int i, Unit& u) const {
        const long L = (long)i * G + c; if (L >= nwg) return false;
        int wgid = (int)L; { const int q = nwg / NXCD, r = nwg % NXCD, xcd = wgid % NXCD, off = wgid / NXCD; wgid = (xcd < r ? xcd * (q + 1) : r * (q + 1) + (xcd - r) * q) + off; }
        const int nig = WGM * nN, gid = wgid / nig, fm = gid * WGM, gsz = (nM - fm) < WGM ? (nM - fm) : WGM;
        u.pm = fm + ((wgid % nig) % gsz); u.pn = (wgid % nig) / gsz; return true;
    }
    __device__ __forceinline__ void a_ready(const Unit&) const {}
    __device__ __forceinline__ void done(const Unit&) const {}
};


typedef float cvt_f32x2_t __attribute__((ext_vector_type(2))); typedef __bf16 cvt_bf16x2_t __attribute__((ext_vector_type(2)));
__device__ __forceinline__ unsigned cvt_pk_bf16(float lo, float hi) { cvt_f32x2_t v = {lo, hi}; cvt_bf16x2_t b = __builtin_convertvector(v, cvt_bf16x2_t); return __builtin_bit_cast(unsigned, b); }
__device__ __forceinline__ float bf_lo(unsigned w) { return __uint_as_float(w << 16); }
__device__ __forceinline__ float bf_hi(unsigned w) { return __uint_as_float(w & 0xffff0000u); }

struct EpiInProj {
    static constexpr bool PERM = true, AFTER_DRAIN = false;
    bf16_t* Z; bf16_t* G; const float* bgate; float qscale;
    __device__ __forceinline__ void operator()(const f32x4 (&acc)[2][2][4][2], const Unit& u, int wr, int wc, int fr, int fq) const {
        asm volatile("" : "+v"(fr), "+v"(fq));
        const int row0 = u.pm * BM + wr * 64 + fr; const int colw = wc * 32 + 8 * fq;
        if (u.pn < 9) {
            const float sc = (u.pn < 2) ? qscale : 1.f;
            bf16_t* base = Z + u.pn * BM + colw;
#pragma unroll
            for (int ai = 0; ai < 2; ++ai)
#pragma unroll
                for (int m = 0; m < 4; ++m) { bf16_t* rowp = base + (size_t)(row0 + ai * HALF + m * 16) * 2304;
#pragma unroll
                    for (int bj = 0; bj < 2; ++bj) { f32x4 v0 = acc[ai][bj][m][0] * sc, v1 = acc[ai][bj][m][1] * sc;
                        u32x4 w; w.x = cvt_pk_bf16(v0[0], v0[1]); w.y = cvt_pk_bf16(v0[2], v0[3]); w.z = cvt_pk_bf16(v1[0], v1[1]); w.w = cvt_pk_bf16(v1[2], v1[3]);
                        *(u32x4*)(rowp + bj * HALF) = w; } }
        } else {
            const int gc = (u.pn - 9) * BM + colw;
            bf16_t* base = G + gc;
            f32x4 bv[2][2];
#pragma unroll
            for (int bj = 0; bj < 2; ++bj)
#pragma unroll
                for (int n = 0; n < 2; ++n) bv[bj][n] = *(const f32x4*)(bgate + gc + bj * HALF + 4 * n);
#pragma unroll
            for (int ai = 0; ai < 2; ++ai)
#pragma unroll
                for (int m = 0; m < 4; ++m) { bf16_t* rowp = base + (size_t)(row0 + ai * HALF + m * 16) * 2048;
#pragma unroll
                    for (int bj = 0; bj < 2; ++bj) { f32x4 v0 = acc[ai][bj][m][0] + bv[bj][0], v1 = acc[ai][bj][m][1] + bv[bj][1];
#pragma unroll
                        for (int e = 0; e < 4; ++e) { v0[e] = __builtin_amdgcn_rcpf(1.f + __builtin_amdgcn_exp2f(-1.4426950408889634f * v0[e])); v1[e] = __builtin_amdgcn_rcpf(1.f + __builtin_amdgcn_exp2f(-1.4426950408889634f * v1[e])); }
                        u32x4 w; w.x = cvt_pk_bf16(v0[0], v0[1]); w.y = cvt_pk_bf16(v0[2], v0[3]); w.z = cvt_pk_bf16(v1[0], v1[1]); w.w = cvt_pk_bf16(v1[2], v1[3]);
                        *(u32x4*)(rowp + bj * HALF) = w; } }
        }
    }
};
template <bool ADD> struct EpiGate {
    static constexpr bool PERM = true, AFTER_DRAIN = false;
    bf16_t* U; const bf16_t* G; int goff;
    __device__ __forceinline__ void operator()(const f32x4 (&acc)[2][2][4][2], const Unit& u, int wr, int wc, int fr, int fq) const {
        asm volatile("" : "+v"(fr), "+v"(fq));
        const int row0 = u.pm * BM + wr * 64 + fr; const int col0 = u.pn * BM + wc * 32 + 8 * fq;
#pragma unroll
        for (int ai = 0; ai < 2; ++ai)
#pragma unroll
            for (int m = 0; m < 4; ++m) { const size_t r = (size_t)(row0 + ai * HALF + m * 16);
#pragma unroll
                for (int bj = 0; bj < 2; ++bj) {
                    const u32x4 g = *(const u32x4*)(G + r * 2048 + goff + col0 + bj * HALF);
                    f32x4 v0 = acc[ai][bj][m][0], v1 = acc[ai][bj][m][1];
                    v0[0] *= bf_lo(g.x); v0[1] *= bf_hi(g.x); v0[2] *= bf_lo(g.y); v0[3] *= bf_hi(g.y);
                    v1[0] *= bf_lo(g.z); v1[1] *= bf_hi(g.z); v1[2] *= bf_lo(g.w); v1[3] *= bf_hi(g.w);
                    bf16_t* op = U + r * 1024 + col0 + bj * HALF;
                    if (ADD) { const u32x4 p = *(const u32x4*)op;
                        v0[0] += bf_lo(p.x); v0[1] += bf_hi(p.x); v0[2] += bf_lo(p.y); v0[3] += bf_hi(p.y);
                        v1[0] += bf_lo(p.z); v1[1] += bf_hi(p.z); v1[2] += bf_lo(p.w); v1[3] += bf_hi(p.w); }
                    u32x4 w; w.x = cvt_pk_bf16(v0[0], v0[1]); w.y = cvt_pk_bf16(v0[2], v0[3]); w.z = cvt_pk_bf16(v1[0], v1[1]); w.w = cvt_pk_bf16(v1[2], v1[3]);
                    *(u32x4*)op = w; }
                asm volatile("" ::: "memory"); }
    }
};
struct EpiRelu2 {
    static constexpr bool PERM = true, AFTER_DRAIN = false;
    bf16_t* O;
    __device__ __forceinline__ void operator()(const f32x4 (&acc)[2][2][4][2], const Unit& u, int wr, int wc, int fr, int fq) const {
        asm volatile("" : "+v"(fr), "+v"(fq));
        const int row0 = u.pm * BM + wr * 64 + fr; const int col0 = u.pn * BM + wc * 32 + 8 * fq;
#pragma unroll
        for (int ai = 0; ai < 2; ++ai)
#pragma unroll
            for (int m = 0; m < 4; ++m) { bf16_t* rowp = O + (size_t)(row0 + ai * HALF + m * 16) * 4096 + col0;
#pragma unroll
                for (int bj = 0; bj < 2; ++bj) { f32x4 v0 = acc[ai][bj][m][0], v1 = acc[ai][bj][m][1];
#pragma unroll
                    for (int e = 0; e < 4; ++e) { const float a = fmaxf(v0[e], 0.f), b = fmaxf(v1[e], 0.f); v0[e] = a * a; v1[e] = b * b; }
                    u32x4 w; w.x = cvt_pk_bf16(v0[0], v0[1]); w.y = cvt_pk_bf16(v0[2], v0[3]); w.z = cvt_pk_bf16(v1[0], v1[1]); w.w = cvt_pk_bf16(v1[2], v1[3]);
                    *(u32x4*)(rowp + bj * HALF) = w; } }
    }
};
struct EpiResid {
    static constexpr bool PERM = false, AFTER_DRAIN = false;
    const float* baseP; const float* baseS; float* out; int prow0, srow0;
    __device__ __forceinline__ void operator()(const f32x4 (&acc)[2][2][4][2], const Unit& u, int wr, int wc, int fr, int fq) const {
        asm volatile("" : "+v"(fr), "+v"(fq));
        const int lrow = u.pm * BM; const bool isP = lrow < 32768;
        const int grow = isP ? prow0 + lrow : srow0 + (lrow - 32768);
        const float* bp = isP ? baseP + (size_t)grow * 1024 : baseS + (size_t)(grow - 65536) * 1024;
        float* op = out + (size_t)grow * 1024;
        const int roff = wr * 64 + fr; const int col0 = u.pn * BM + wc * 32 + 4 * fq;
#pragma unroll
        for (int ai = 0; ai < 2; ++ai)
#pragma unroll
            for (int m = 0; m < 4; ++m) { const size_t off = (size_t)(roff + ai * HALF + m * 16) * 1024 + col0;
#pragma unroll
                for (int bj = 0; bj < 2; ++bj)
#pragma unroll
                    for (int n = 0; n < 2; ++n) { const f32x4 b = *(const f32x4*)(bp + off + bj * HALF + n * 16); *(f32x4*)(op + off + bj * HALF + n * 16) = b + acc[ai][bj][m][n]; }
                asm volatile("" ::: "memory"); }
    }
};

template <class Epi, class Sched, bool ALIGN_EPI = false, bool SP2 = false>
__device__ __forceinline__ void gemm_phase(PG8_LAS unsigned char* lds, const Gemm g, const Sched& S, const Epi& E, const int wave_s) {
    int tid = wave_s * 64 + (int)__builtin_amdgcn_mbcnt_hi(~0u, __builtin_amdgcn_mbcnt_lo(~0u, 0u)); asm volatile("" : "+v"(tid));
    const int wid = __builtin_amdgcn_readfirstlane(tid >> 6), lane = tid & 63, wr = wid >> 2, wc = wid & 3, fr = lane & 15, fq = lane >> 4;
    const int K = g.K, nt = K / BK;
    unsigned voffA[2], voffB[2];
#pragma unroll
    for (int i = 0; i < 2; ++i) { int R, C; stage_rc(tid * 16 + i * 8192, R, C); const int Rb = Epi::PERM ? ((R & ~31) + perm32(R & 31)) : R;
        voffA[i] = (unsigned)(R * g.lda + C) * 2u; voffB[i] = (unsigned)(Rb * g.ldb + C) * 2u; }
    const size_t kstep = (size_t)(BK * 2);
    const size_t hstepA = (size_t)HALF * g.lda * 2, hstepB = (size_t)HALF * g.ldb * 2;
    const size_t tstepA = 2 * hstepA, tstepB = 2 * hstepB;
    const unsigned ldsw = (unsigned)wid * 1024u;
    const int aoff = lds_byte(wr * 64 + fr, fq * 8), boff = lds_byte(wc * 32 + fr, fq * 8);
#define PG8_SA(b, h) (((b) * 2 + (h)) * HTB)
#define PG8_SB(b, h) ((4 + (b) * 2 + (h)) * HTB)
#define PG8_STAGE(bufoff, gbase, voff) do { _Pragma("unroll") for (int _i = 0; _i < 2; ++_i) \
        __builtin_amdgcn_global_load_lds((const unsigned*)((const char*)(gbase) + (voff)[_i]), (PG8_LAS unsigned*)(lds + (bufoff) + ldsw + _i * 8192), 16, 0, 0); } while (0)
#define PG8_LDA(dst, b, h) do { _Pragma("unroll") for (int m = 0; m < 4; ++m) _Pragma("unroll") for (int k = 0; k < 2; ++k) dst[m][k] = *(const PG8_LAS bf16x8*)(lds + PG8_SA(b, h) + aoff + m * 2048 + k * 1024); } while (0)
#define PG8_LDB(dst, b, h) do { _Pragma("unroll") for (int n = 0; n < 2; ++n) _Pragma("unroll") for (int k = 0; k < 2; ++k) dst[n][k] = *(const PG8_LAS bf16x8*)(lds + PG8_SB(b, h) + boff + n * 2048 + k * 1024); } while (0)
#define PG8_MMA(ai, bj, At, Bt) do { __builtin_amdgcn_s_setprio(1); _Pragma("unroll") for (int m = 0; m < 4; ++m) _Pragma("unroll") for (int n = 0; n < 2; ++n) _Pragma("unroll") for (int k = 0; k < 2; ++k) \
        acc[ai][bj][m][n] = __builtin_amdgcn_mfma_f32_16x16x32_bf16(Bt[n][k], At[m][k], acc[ai][bj][m][n], 0, 0, 0); __builtin_amdgcn_s_setprio(0); } while (0)
#define PG8_WAIT_V(n) asm volatile("s_waitcnt vmcnt(" #n ")" ::: "memory")
#define PG8_WAIT_L(n) asm volatile("s_waitcnt lgkmcnt(" #n ")" ::: "memory")
#define PG8_BAR __builtin_amdgcn_s_barrier()
#define PG8_SCHED __builtin_amdgcn_sched_barrier(0)
    Unit cur, nxt; int ui = 0;
    if (!S.next(0, cur)) return;
    f32x4 acc[2][2][4][2];
#pragma unroll
    for (int a = 0; a < 2; ++a)
#pragma unroll
        for (int b = 0; b < 2; ++b)
#pragma unroll
            for (int m = 0; m < 4; ++m)
#pragma unroll
                for (int n = 0; n < 2; ++n) acc[a][b][m][n] = (f32x4){0.f, 0.f, 0.f, 0.f};
    bf16x8 At[4][2], B0[2][2], B1[2][2];
    const char* cA = (const char*)g.A + (size_t)cur.pm * tstepA; const char* cB = (const char*)g.Bt + (size_t)cur.pn * tstepB;
    S.a_ready(cur);
    if constexpr (SP2) {
        PG8_STAGE(PG8_SB(0, 0), cB, voffB); PG8_STAGE(PG8_SB(0, 1), cB + hstepB, voffB); PG8_STAGE(PG8_SA(0, 0), cA, voffA); PG8_STAGE(PG8_SA(0, 1), cA + hstepA, voffA);
        if (wr == 1) PG8_BAR;
        PG8_WAIT_V(2); PG8_BAR;
        PG8_STAGE(PG8_SB(1, 0), cB + kstep, voffB); PG8_STAGE(PG8_SA(1, 0), cA + kstep, voffA); PG8_STAGE(PG8_SB(1, 1), cB + hstepB + kstep, voffB);
        PG8_WAIT_V(6); PG8_BAR;
    } else {
        PG8_STAGE(PG8_SB(0, 0), cB, voffB); PG8_STAGE(PG8_SA(0, 0), cA, voffA); PG8_STAGE(PG8_SB(0, 1), cB + hstepB, voffB); PG8_STAGE(PG8_SA(0, 1), cA + hstepA, voffA);
        if (wr == 1) PG8_BAR;
        PG8_WAIT_V(4); PG8_BAR;
        PG8_STAGE(PG8_SB(1, 0), cB + kstep, voffB); PG8_STAGE(PG8_SA(1, 0), cA + kstep, voffA); PG8_STAGE(PG8_SB(1, 1), cB + hstepB + kstep, voffB);
        PG8_WAIT_V(6); PG8_BAR;
    }
    for (;;) {
        const bool has_next = S.next(ui + 1, nxt);
        const char* nA = has_next ? (const char*)g.A + (size_t)nxt.pm * tstepA : cA; const char* nB = has_next ? (const char*)g.Bt + (size_t)nxt.pn * tstepB : cB;
        for (int t = 0; t < nt; t += 2) {
            const bool last = (t == nt - 2);
            const char* a1 = cA + (size_t)(t + 1) * kstep;
            const char* a2 = last ? nA : cA + (size_t)(t + 2) * kstep; const char* b2 = last ? nB : cB + (size_t)(t + 2) * kstep;
            const char* a3 = a2 + kstep; const char* b3 = b2 + kstep;
            if (last && has_next) S.a_ready(nxt);
            if constexpr (SP2) {
            PG8_LDB(B0, 0, 0); PG8_LDB(B1, 0, 1); PG8_SCHED; PG8_LDA(At, 0, 0); PG8_STAGE(PG8_SA(1, 1), a1 + hstepA, voffA);
            PG8_WAIT_V(8); PG8_WAIT_L(0); PG8_BAR; PG8_MMA(0, 0, At, B0); PG8_MMA(0, 1, At, B1); PG8_BAR; PG8_SCHED;
            PG8_LDA(At, 0, 1); PG8_STAGE(PG8_SB(0, 0), b2, voffB); PG8_STAGE(PG8_SB(0, 1), b2 + hstepB, voffB); PG8_STAGE(PG8_SA(0, 0), a2, voffA);
            PG8_WAIT_V(8); PG8_WAIT_L(0); PG8_BAR; PG8_MMA(1, 0, At, B0); PG8_MMA(1, 1, At, B1); PG8_BAR; PG8_SCHED;
            PG8_LDB(B0, 1, 0); PG8_LDB(B1, 1, 1); PG8_SCHED; PG8_LDA(At, 1, 0); PG8_STAGE(PG8_SA(0, 1), a2 + hstepA, voffA);
            PG8_WAIT_V(8); PG8_WAIT_L(0); PG8_BAR; PG8_MMA(0, 0, At, B0); PG8_MMA(0, 1, At, B1); PG8_BAR; PG8_SCHED;
            PG8_LDA(At, 1, 1); PG8_STAGE(PG8_SB(1, 0), b3, voffB); PG8_STAGE(PG8_SB(1, 1), b3 + hstepB, voffB); PG8_STAGE(PG8_SA(1, 0), a3, voffA);
            PG8_WAIT_V(8); PG8_WAIT_L(0); PG8_BAR; PG8_MMA(1, 0, At, B0); PG8_MMA(1, 1, At, B1); PG8_BAR; PG8_SCHED;
            } else {
            PG8_LDB(B0, 0, 0); PG8_SCHED; PG8_LDA(At, 0, 0); PG8_STAGE(PG8_SA(1, 1), a1 + hstepA, voffA);
            PG8_WAIT_L(8); PG8_BAR; PG8_WAIT_L(0); PG8_MMA(0, 0, At, B0); PG8_BAR; PG8_SCHED;
            PG8_LDB(B1, 0, 1); PG8_STAGE(PG8_SB(0, 0), b2, voffB);
            PG8_BAR; PG8_WAIT_L(0); PG8_MMA(0, 1, At, B1); PG8_BAR;
            PG8_LDA(At, 0, 1); PG8_STAGE(PG8_SA(0, 0), a2, voffA);
            PG8_BAR; PG8_WAIT_L(0); PG8_MMA(1, 0, At, B0); PG8_BAR; PG8_SCHED;
            PG8_STAGE(PG8_SB(0, 1), b2 + hstepB, voffB);
            PG8_WAIT_V(6); PG8_BAR; PG8_MMA(1, 1, At, B1); PG8_BAR;
            PG8_LDB(B0, 1, 0); PG8_SCHED; PG8_LDA(At, 1, 0); PG8_STAGE(PG8_SA(0, 1), a2 + hstepA, voffA);
            PG8_WAIT_L(8); PG8_BAR; PG8_WAIT_L(0); PG8_MMA(0, 0, At, B0); PG8_BAR; PG8_SCHED;
            PG8_LDB(B1, 1, 1); PG8_STAGE(PG8_SB(1, 0), b3, voffB);
            PG8_BAR; PG8_WAIT_L(0); PG8_MMA(0, 1, At, B1); PG8_BAR;
            PG8_LDA(At, 1, 1); PG8_STAGE(PG8_SA(1, 0), a3, voffA);
            PG8_BAR; PG8_WAIT_L(0); PG8_MMA(1, 0, At, B0); PG8_BAR; PG8_SCHED;
            PG8_STAGE(PG8_SB(1, 1), b3 + hstepB, voffB);
            PG8_WAIT_V(6); PG8_BAR; PG8_MMA(1, 1, At, B1); PG8_BAR;
            }
        }
        if constexpr (ALIGN_EPI) { if (wr == 0) PG8_BAR; }
        if constexpr (!Epi::AFTER_DRAIN) { E(acc, cur, wr, wc, fr, fq); S.done(cur); }
        if (!has_next) break;
#pragma unroll
        for (int a = 0; a < 2; ++a)
#pragma unroll
            for (int b = 0; b < 2; ++b)
#pragma unroll
                for (int m = 0; m < 4; ++m)
#pragma unroll
                    for (int n = 0; n < 2; ++n) acc[a][b][m][n] = (f32x4){0.f, 0.f, 0.f, 0.f};
        cur = nxt; cA = nA; cB = nB; ++ui;
        if constexpr (ALIGN_EPI) { if (wr == 1) PG8_BAR; }
    }
    PG8_WAIT_V(0);
    if constexpr (!ALIGN_EPI) { if (wr == 0) PG8_BAR; }
    PG8_BAR;
    if constexpr (Epi::AFTER_DRAIN) { E.fused(acc, cur, wr, wc, fr, fq, lds, wid, lane); S.done(cur); }
#undef PG8_SA
#undef PG8_SB
#undef PG8_STAGE
#undef PG8_LDA
#undef PG8_LDB
#undef PG8_MMA
#undef PG8_WAIT_V
#undef PG8_WAIT_L
#undef PG8_BAR
#undef PG8_SCHED
}

template <class Epi, class Sched>
__device__ __forceinline__ void gemm_phase2(PG8_LAS unsigned char* lds, const Gemm g, const Sched& S, const Epi& E, const int wave_s) {
    int tid = wave_s * 64 + (int)__builtin_amdgcn_mbcnt_hi(~0u, __builtin_amdgcn_mbcnt_lo(~0u, 0u)); asm volatile("" : "+v"(tid));
    const int wid = __builtin_amdgcn_readfirstlane(tid >> 6), lane = tid & 63, wr = wid >> 2, wc = wid & 3, fr = lane & 15, fq = lane >> 4;
    const int K = g.K, nt = K / BK;
    unsigned voffA[2], voffB[2];
#pragma unroll
    for (int i = 0; i < 2; ++i) { int R, C; stage_rc(tid * 16 + i * 8192, R, C); const int Rb = Epi::PERM ? ((R & ~31) + perm32(R & 31)) : R;
        voffA[i] = (unsigned)(R * g.lda + C) * 2u; voffB[i] = (unsigned)(Rb * g.ldb + C) * 2u; }
    const size_t kstep = (size_t)(BK * 2);
    const size_t hstepA = (size_t)HALF * g.lda * 2, hstepB = (size_t)HALF * g.ldb * 2;
    const size_t tstepA = 2 * hstepA, tstepB = 2 * hstepB;
    const unsigned ldst = (unsigned)tid * 16u;
    const int aoff = lds_byte(wr * 64 + fr, fq * 8), boff = lds_byte(wc * 32 + fr, fq * 8);
#define PG8_SA(b, h) (((b) * 2 + (h)) * HTB)
#define PG8_SB(b, h) ((4 + (b) * 2 + (h)) * HTB)
#define PG8_LDA(dst, b, h) do { _Pragma("unroll") for (int m = 0; m < 4; ++m) _Pragma("unroll") for (int k = 0; k < 2; ++k) dst[m][k] = *(const PG8_LAS bf16x8*)(lds + PG8_SA(b, h) + aoff + m * 2048 + k * 1024); } while (0)
#define PG8_LDB(dst, b, h) do { _Pragma("unroll") for (int n = 0; n < 2; ++n) _Pragma("unroll") for (int k = 0; k < 2; ++k) dst[n][k] = *(const PG8_LAS bf16x8*)(lds + PG8_SB(b, h) + boff + n * 2048 + k * 1024); } while (0)
#define PG8_MMA(ai, bj, At, Bt) do { _Pragma("unroll") for (int m = 0; m < 4; ++m) _Pragma("unroll") for (int n = 0; n < 2; ++n) _Pragma("unroll") for (int k = 0; k < 2; ++k) \
        acc[ai][bj][m][n] = __builtin_amdgcn_mfma_f32_16x16x32_bf16(Bt[n][k], At[m][k], acc[ai][bj][m][n], 0, 0, 0); } while (0)
    Unit cur;
    for (int ui = 0; S.next(ui, cur); ++ui) {
        f32x4 acc[2][2][4][2];
#pragma unroll
        for (int a = 0; a < 2; ++a)
#pragma unroll
            for (int b = 0; b < 2; ++b)
#pragma unroll
                for (int m = 0; m < 4; ++m)
#pragma unroll
                    for (int n = 0; n < 2; ++n) acc[a][b][m][n] = (f32x4){0.f, 0.f, 0.f, 0.f};
        const char* cA = (const char*)g.A + (size_t)cur.pm * tstepA; const char* cB = (const char*)g.Bt + (size_t)cur.pn * tstepB;
        u32x4 ra[2][2], rb[2][2];
#pragma unroll
        for (int h = 0; h < 2; ++h)
#pragma unroll
            for (int i = 0; i < 2; ++i) { ra[h][i] = *(const u32x4*)(cA + h * hstepA + voffA[i]); rb[h][i] = *(const u32x4*)(cB + h * hstepB + voffB[i]); }
        for (int t = 0; t < nt; ++t) {
            const int b = t & 1;
#pragma unroll
            for (int h = 0; h < 2; ++h)
#pragma unroll
                for (int i = 0; i < 2; ++i) { *(PG8_LAS u32x4*)(lds + PG8_SA(b, h) + ldst + i * 8192) = ra[h][i]; *(PG8_LAS u32x4*)(lds + PG8_SB(b, h) + ldst + i * 8192) = rb[h][i]; }
            __syncthreads();
            if (t + 1 < nt) {
                const char* nA = cA + (size_t)(t + 1) * kstep; const char* nB = cB + (size_t)(t + 1) * kstep;
#pragma unroll
                for (int h = 0; h < 2; ++h)
#pragma unroll
                    for (int i = 0; i < 2; ++i) { ra[h][i] = *(const u32x4*)(nA + h * hstepA + voffA[i]); rb[h][i] = *(const u32x4*)(nB + h * hstepB + voffB[i]); }
            }
            bf16x8 At[4][2], B0[2][2];
            PG8_LDB(B0, b, 0); PG8_LDA(At, b, 0); PG8_MMA(0, 0, At, B0); __builtin_amdgcn_sched_barrier(0);
            PG8_LDA(At, b, 1); PG8_MMA(1, 0, At, B0); __builtin_amdgcn_sched_barrier(0);
            PG8_LDB(B0, b, 1); PG8_MMA(1, 1, At, B0); __builtin_amdgcn_sched_barrier(0);
            PG8_LDA(At, b, 0); PG8_MMA(0, 1, At, B0); __builtin_amdgcn_sched_barrier(0);
        }
        E(acc, cur, wr, wc, fr, fq);
    }
    __syncthreads();
#undef PG8_SA
#undef PG8_SB
#undef PG8_LDA
#undef PG8_LDB
#undef PG8_MMA
}
}


#define LAS __attribute__((address_space(3)))
#define GAS __attribute__((address_space(1)))
typedef unsigned short bf16;
typedef short bf16x8 __attribute__((ext_vector_type(8)));
typedef float f32x4 __attribute__((ext_vector_type(4)));
typedef float f32x16 __attribute__((ext_vector_type(16)));
typedef unsigned u32x4 __attribute__((ext_vector_type(4)));
typedef unsigned u32x2 __attribute__((ext_vector_type(2)));
typedef float f32x2 __attribute__((ext_vector_type(2)));

constexpr int DM = 1024, DFF = 4096, INC = 4352, ZLD = 2304, GLD = 2048;
constexpr int NP = 8192, NS = 4096;
constexpr int MC = 49152;
constexpr int MC_P = 32768;
constexpr int MTOT = 98304, MPROMPT = 65536;
constexpr float C2 = 0.125f * 1.4426950408889634f;
constexpr float LOG2E = 1.4426950408889634f;
constexpr int NWAVES = 8, NTHR = 512;

constexpr size_t MiB = 1u << 20;
constexpr size_t WS_CTL = 0;
constexpr size_t WS_WIN = 1 * MiB;
constexpr size_t WS_WUA = WS_WIN + (size_t)2 * INC * DM * 2;
constexpr size_t WS_WUB = WS_WUA + (size_t)2 * DM * 512 * 2;
constexpr size_t WS_WO  = WS_WUB + (size_t)2 * DM * 512 * 2;
constexpr size_t WS_W1  = WS_WO + (size_t)2 * DM * DM * 2;
constexpr size_t WS_W2  = WS_W1 + (size_t)2 * DFF * DM * 2;
constexpr size_t WS_WEND = WS_W2 + (size_t)2 * DFF * DM * 2;
static_assert(WS_WEND <= 64 * MiB, "weights");
constexpr size_t WS_H = 64 * MiB;
constexpr size_t WS_OAB = 160 * MiB;
constexpr size_t WS_U = 256 * MiB;
constexpr size_t WS_Z = 352 * MiB;
constexpr size_t WS_G = 568 * MiB;
constexpr size_t WS_VTA = 760 * MiB;
constexpr size_t WS_VTB = 808 * MiB;
constexpr size_t WS_END = 820 * MiB;
constexpr size_t WS_ACT = 352 * MiB;
static_assert(WS_ACT + (size_t)MC * DFF * 2 <= WS_VTA, "act overlay");

constexpr int RING_BYTES = 131072;
constexpr int MISC_OFF = RING_BYTES;
constexpr int BT_N = 513;
constexpr int PTAB_OFF = MISC_OFF + 8320;
constexpr int WSF_OFF = MISC_OFF + 8576;
constexpr int LDS_BYTES = RING_BYTES + 8576 + 1024;
static_assert(64 + 4 * BT_N * 4 <= 8320, "lds");

struct Params {
    const float* in[20];
    float* out; unsigned char* ws;
};

__device__ __forceinline__ unsigned cvtpk(float lo, float hi) { return pg8::cvt_pk_bf16(lo, hi); }
__device__ __forceinline__ float bflo(unsigned w) { return __uint_as_float(w << 16); }
__device__ __forceinline__ float bfhi(unsigned w) { return __uint_as_float(w & 0xffff0000u); }
__device__ __forceinline__ float bf2f(bf16 v) { return __uint_as_float((unsigned)v << 16); }
__device__ __forceinline__ bf16 f2bf(float f) { return (bf16)(cvtpk(f, 0.f) & 0xffffu); }
__device__ __forceinline__ float bperm(float v, int byteaddr) { return __int_as_float(__builtin_amdgcn_ds_bpermute(byteaddr, __float_as_int(v))); }
__device__ __forceinline__ float wave_sum(float v, int lane) {
#pragma unroll
    for (int o = 1; o < 64; o <<= 1) v += bperm(v, (lane ^ o) << 2);
    return v;
}
__device__ __forceinline__ float half_sum(float v, int lane) {
#pragma unroll
    for (int o = 1; o < 32; o <<= 1) v += bperm(v, (lane ^ o) << 2);
    return v;
}
__device__ __forceinline__ float xmax32(float v) { auto rr = __builtin_amdgcn_permlane32_swap(__float_as_uint(v), __float_as_uint(v), false, false); return fmaxf(__uint_as_float(rr[0]), __uint_as_float(rr[1])); }
__device__ __forceinline__ float xsum32(float v) { auto rr = __builtin_amdgcn_permlane32_swap(__float_as_uint(v), __float_as_uint(v), false, false); return __uint_as_float(rr[0]) + __uint_as_float(rr[1]); }
__device__ __forceinline__ int my_tid(int wave) { int t = wave * 64 + (int)__builtin_amdgcn_mbcnt_hi(~0u, __builtin_amdgcn_mbcnt_lo(~0u, 0u)); asm volatile("" : "+v"(t)); return t; }
__device__ __forceinline__ int crow(int r, int hi) { return (r & 3) + 8 * (r >> 2) + 4 * hi; }

__device__ __forceinline__ void p0_transpose_item(const float* W, int K, int N, bf16* WT, LAS float* scr, int item, int lane) {
    const int nblk = N / 32, kb = item / nblk, nb = item % nblk, k0 = 64 * kb, n0 = 32 * nb;
    const GAS float* Wg = (const GAS float*)W + (size_t)(k0 + (lane >> 5)) * N + n0 + (lane & 31);
#pragma unroll
    for (int h = 0; h < 2; ++h) {
        float wv[16];
#pragma unroll
        for (int i = 0; i < 16; ++i) wv[i] = Wg[(size_t)(2 * (16 * h + i)) * N];
#pragma unroll
        for (int i = 0; i < 16; ++i) { const int kk = 2 * (16 * h + i) + (lane >> 5); scr[kk * 33 + (lane & 31)] = wv[i]; }
    }
    asm volatile("s_waitcnt lgkmcnt(0)" ::: "memory");
    const int c = lane & 7;
#pragma unroll
    for (int j = 0; j < 4; ++j) { const int n = (lane >> 3) + 8 * j; const LAS float* s = scr + (8 * c) * 33 + n;
        u32x4 o; o.x = cvtpk(s[0 * 33], s[1 * 33]); o.y = cvtpk(s[2 * 33], s[3 * 33]); o.z = cvtpk(s[4 * 33], s[5 * 33]); o.w = cvtpk(s[6 * 33], s[7 * 33]);
        *(GAS u32x4*)(WT + (size_t)(n0 + n) * K + k0 + 8 * c) = o; }
    asm volatile("s_waitcnt lgkmcnt(0)" ::: "memory");
}

__device__ __forceinline__ void rms_row_to_bf16(const float* xrow, const float* g, bf16* orow, int lane) {
    const GAS f32x4* xr = (const GAS f32x4*)xrow + lane; const GAS f32x4* gr = (const GAS f32x4*)g + lane;
    f32x4 v[4]; float s = 0.f;
#pragma unroll
    for (int j = 0; j < 4; ++j) { v[j] = xr[64 * j]; s += (v[j].x * v[j].x + v[j].y * v[j].y) + (v[j].z * v[j].z + v[j].w * v[j].w); }
    const float rstd = 1.f / sqrtf(wave_sum(s, lane) * (1.f / DM) + 1e-6f);
    GAS u32x2* o8 = (GAS u32x2*)orow + lane;
#pragma unroll
    for (int j = 0; j < 4; ++j) { const f32x4 gg = gr[64 * j]; u32x2 w; w.x = cvtpk(v[j].x * rstd * gg.x, v[j].y * rstd * gg.y); w.y = cvtpk(v[j].z * rstd * gg.z, v[j].w * rstd * gg.w); o8[64 * j] = w; }
}
__device__ __forceinline__ void rms_row2_to_bf16(const float* xrow0, const float* xrow1, const float* g, bf16* orow0, bf16* orow1, int lane) {
    const GAS f32x4* x0 = (const GAS f32x4*)xrow0 + lane; const GAS f32x4* x1 = (const GAS f32x4*)xrow1 + lane; const GAS f32x4* gr = (const GAS f32x4*)g + lane;
    f32x4 v0[4], v1[4]; float s0 = 0.f, s1 = 0.f;
#pragma unroll
    for (int j = 0; j < 4; ++j) { v0[j] = x0[64 * j]; v1[j] = x1[64 * j]; }
#pragma unroll
    for (int j = 0; j < 4; ++j) { s0 += (v0[j].x * v0[j].x + v0[j].y * v0[j].y) + (v0[j].z * v0[j].z + v0[j].w * v0[j].w); s1 += (v1[j].x * v1[j].x + v1[j].y * v1[j].y) + (v1[j].z * v1[j].z + v1[j].w * v1[j].w); }
#pragma unroll
    for (int o = 1; o < 64; o <<= 1) { s0 += bperm(s0, (lane ^ o) << 2); s1 += bperm(s1, (lane ^ o) << 2); }
    const float r0 = 1.f / sqrtf(s0 * (1.f / DM) + 1e-6f), r1 = 1.f / sqrtf(s1 * (1.f / DM) + 1e-6f);
    GAS u32x2* o0 = (GAS u32x2*)orow0 + lane; GAS u32x2* o1 = (GAS u32x2*)orow1 + lane;
#pragma unroll
    for (int j = 0; j < 4; ++j) { const f32x4 gg = gr[64 * j];
        u32x2 w; w.x = cvtpk(v0[j].x * r0 * gg.x, v0[j].y * r0 * gg.y); w.y = cvtpk(v0[j].z * r0 * gg.z, v0[j].w * r0 * gg.w); o0[64 * j] = w;
        u32x2 u; u.x = cvtpk(v1[j].x * r1 * gg.x, v1[j].y * r1 * gg.y); u.y = cvtpk(v1[j].z * r1 * gg.z, v1[j].w * r1 * gg.w); o1[64 * j] = u; }
}
__device__ __forceinline__ void rms_row_f32_inplace(float* xrow, const float* g, int lane) {
    GAS f32x4* xr = (GAS f32x4*)xrow + lane; const GAS f32x4* gr = (const GAS f32x4*)g + lane;
    f32x4 v[4]; float s = 0.f;
#pragma unroll
    for (int j = 0; j < 4; ++j) { v[j] = xr[64 * j]; s += (v[j].x * v[j].x + v[j].y * v[j].y) + (v[j].z * v[j].z + v[j].w * v[j].w); }
    const float rstd = 1.f / sqrtf(wave_sum(s, lane) * (1.f / DM) + 1e-6f);
#pragma unroll
    for (int j = 0; j < 4; ++j) { const f32x4 gg = gr[64 * j]; xr[64 * j] = v[j] * rstd * gg; }
}

__device__ __forceinline__ void prepass_tile(bf16* Z, bf16* VtA, bf16* VtB, const float* gq, const float* gk, int m0, int tok0, int N, LAS unsigned char* lds, int wave, int lane) {
    asm volatile("" : "+v"(lane));
    for (int pass = 0; pass < 2; ++pass) {
        const int it = wave * 80 + pass * 64 + lane;
        if (pass == 1 && lane >= 16) break;
        const int tk = it / 10, hd = it - tk * 10;
        const int mrow = m0 + tk, n = mrow - tok0;
        const bool isq = hd < 8;
        GAS u32x4* hp = (GAS u32x4*)(Z + (size_t)mrow * ZLD + (isq ? 1536 + hd * 64 : 2048 + (hd - 8) * 64));
        u32x4 w[8];
#pragma unroll
        for (int k = 0; k < 8; ++k) w[k] = hp[k];
        float x[64]; float ss = 0.f;
#pragma unroll
        for (int k = 0; k < 8; ++k) { x[8 * k + 0] = bflo(w[k].x); x[8 * k + 1] = bfhi(w[k].x); x[8 * k + 2] = bflo(w[k].y); x[8 * k + 3] = bfhi(w[k].y);
                                      x[8 * k + 4] = bflo(w[k].z); x[8 * k + 5] = bfhi(w[k].z); x[8 * k + 6] = bflo(w[k].w); x[8 * k + 7] = bfhi(w[k].w); }
#pragma unroll
        for (int d = 0; d < 64; ++d) ss += x[d] * x[d];
        const float rstd = 1.f / sqrtf(ss * (1.f / 64.f) + 1e-6f);
        const float* gg = isq ? gq : gk;
        const float osc = isq ? C2 : 1.f;
        const float prow = (float)(n >> 6), pcol = (float)(n & 63);
#pragma unroll
        for (int j = 0; j < 16; ++j) {
            constexpr float INVT[16] = {1.591549431e-01f, 8.949940161e-02f, 5.032921210e-02f, 2.830219583e-02f, 1.591549431e-02f, 8.949940161e-03f, 5.032921210e-03f, 2.830219583e-03f, 1.591549431e-03f, 8.949940161e-04f, 5.032921210e-04f, 2.830219583e-04f, 1.591549431e-04f, 8.949940161e-05f, 5.032921210e-05f, 2.830219583e-05f};
            const float inv = INVT[j];
            { const float rev = prow * inv, cs = __builtin_amdgcn_cosf(rev), sn = __builtin_amdgcn_sinf(rev);
              const float y1 = x[j] * rstd * gg[j], y2 = x[j + 16] * rstd * gg[j + 16];
              x[j] = (y1 * cs - y2 * sn) * osc; x[j + 16] = (y2 * cs + y1 * sn) * osc; }
            { const float rev = pcol * inv, cs = __builtin_amdgcn_cosf(rev), sn = __builtin_amdgcn_sinf(rev);
              const float y1 = x[32 + j] * rstd * gg[32 + j], y2 = x[48 + j] * rstd * gg[48 + j];
              x[32 + j] = (y1 * cs - y2 * sn) * osc; x[48 + j] = (y2 * cs + y1 * sn) * osc; }
        }
#pragma unroll
        for (int k = 0; k < 8; ++k) { u32x4 o4; o4.x = cvtpk(x[8 * k + 0], x[8 * k + 1]); o4.y = cvtpk(x[8 * k + 2], x[8 * k + 3]); o4.z = cvtpk(x[8 * k + 4], x[8 * k + 5]); o4.w = cvtpk(x[8 * k + 6], x[8 * k + 7]); hp[k] = o4; }
    }
    LAS bf16* scr = (LAS bf16*)(lds + wave * 9216);
    const int n0 = m0 - tok0;
    for (int item = wave; item < 10; item += 8) {
        const int scol = item < 8 ? 1024 + 64 * item : 2176 + 64 * (item - 8);
        bf16* dst = item < 8 ? VtA + (size_t)tok0 * 512 + (size_t)(64 * item) * N : VtB + (size_t)tok0 * 128 + (size_t)(64 * (item - 8)) * N;
        u32x4 v[8];
#pragma unroll
        for (int it = 0; it < 8; ++it) { const int row = 8 * it + (lane >> 3), ch = lane & 7; v[it] = *(const GAS u32x4*)(Z + (size_t)(m0 + row) * ZLD + scol + ch * 8); }
#pragma unroll
        for (int it = 0; it < 8; ++it) { const int row = 8 * it + (lane >> 3), ch = lane & 7; *(LAS u32x4*)(scr + row * 72 + ch * 8) = v[it]; }
        asm volatile("s_waitcnt lgkmcnt(0)" ::: "memory");
#pragma unroll
        for (int it = 0; it < 8; ++it) { const int d = 8 * it + (lane >> 3), ch = lane & 7;
            unsigned short e[8];
#pragma unroll
            for (int k = 0; k < 8; ++k) e[k] = scr[(8 * ch + k) * 72 + d];
            u32x4 w; w.x = e[0] | ((unsigned)e[1] << 16); w.y = e[2] | ((unsigned)e[3] << 16); w.z = e[4] | ((unsigned)e[5] << 16); w.w = e[6] | ((unsigned)e[7] << 16);
            *(GAS u32x4*)(dst + (size_t)d * N + n0 + ch * 8) = w; }
        asm volatile("s_waitcnt lgkmcnt(0)" ::: "memory");
    }
}

template <int KW, int DV, bool BIAS>
__device__ __forceinline__ void attn_core(LAS unsigned char* lds, const bf16* __restrict__ Qw, const bf16* __restrict__ Kg, const bf16* __restrict__ Vtg,
                                          int N, int kc, int qpos0, const LAS float* btab, f32x16 (&o)[DV / 32], const int wave_s) {
    const int tid = my_tid(wave_s);
    const int lane = tid & 63, r32 = lane & 31, hi = lane >> 5;
    constexpr int KPR = KW / 8, KP = 64 * KPR / NTHR, VP = DV * 8 / NTHR;
    constexpr int KBYTES = 64 * KW * 2, VBYTES = DV * 128, BUF = KBYTES + VBYTES;
    constexpr float THR = 8.f;
    const int NT = N / 64;
    const int krow = tid / KPR, kch = tid % KPR, vrow = tid >> 3, vch = tid & 7;
    const int sxk_w = (KW == 128) ? (krow & 15) : ((krow >> 1) & 7);
    LAS unsigned char* const kdst = lds + krow * (KW * 2) + ((kch ^ sxk_w) * 16);
    const int vsx = (vrow >> 1) & 7;
    LAS unsigned char* const vdst0 = lds + KBYTES + vrow * 128 + (((vch & ~1) ^ vsx) * 16) + (vch & 1) * 8;
    LAS unsigned char* const vdst1 = lds + KBYTES + vrow * 128 + (((vch | 1) ^ vsx) * 16) + (vch & 1) * 8;
    constexpr int KDSTEP = (NTHR / KPR) * KW * 2, VDSTEP = 64 * 128;
    const bf16* ksrc = Kg + (size_t)krow * ZLD + kch * 8;
    const bf16* vsrc = Vtg + (size_t)vrow * (size_t)N + vch * 8;
    u32x4 kreg[KP], vreg[VP];
#pragma unroll
    for (int i = 0; i < KP; ++i) kreg[i] = *(const GAS u32x4*)(ksrc + (size_t)((NTHR / KPR) * i) * ZLD);
#pragma unroll
    for (int i = 0; i < VP; ++i) vreg[i] = *(const GAS u32x4*)(vsrc + (size_t)(64 * i) * (size_t)N);
    bf16x8 qr[4];
#pragma unroll
    for (int d0 = 0; d0 < 4; ++d0) qr[d0] = *(const GAS bf16x8*)(Qw + (size_t)r32 * ZLD + d0 * 16 + hi * 8);
    LAS float* wsf = (LAS float*)(lds + WSF_OFF) + (tid >> 6) * 32;
    const LAS unsigned char* kaddr[4]; const LAS unsigned char* vaddr[4];
#pragma unroll
    for (int d0 = 0; d0 < 4; ++d0) kaddr[d0] = lds + r32 * (KW * 2) + (((kc / 8 + 2 * d0 + hi) ^ ((KW == 128) ? (r32 & 15) : ((r32 >> 1) & 7))) * 16);
#pragma unroll
    for (int j = 0; j < 4; ++j) vaddr[j] = lds + KBYTES + r32 * 128 + (((2 * j + hi) ^ ((r32 >> 1) & 7)) * 16);
    float cbl = 0.f, cbr = 0.f;
    if (BIAS) { cbl = btab[0]; cbr = btab[512]; }
    const LAS float* btq = btab + (256 + 4 * hi - (qpos0 + r32));
    float mhat = 0.f, l = 0.f;
    constexpr bool NEGM = (!BIAS && DV == 64);
    f32x16 negm = f32x16{};
    float cb = 0.f;
#pragma unroll
    for (int d = 0; d < DV / 32; ++d) o[d] = f32x16{};

#define LDK(PAR, KB) do { _Pragma("unroll") for (int d0 = 0; d0 < 4; ++d0) kf[d0] = *(const LAS bf16x8*)(kaddr[d0] + ((PAR) * BUF + (KB) * 32 * KW * 2)); } while (0)
#define LDV(DST, PAR, DP, KB) do { _Pragma("unroll") for (int dd = 0; dd < 2; ++dd) _Pragma("unroll") for (int jj = 0; jj < 2; ++jj) \
            DST[dd][jj] = *(const LAS u32x4*)(vaddr[2 * (KB) + jj] + ((PAR) * BUF + ((DP) * 2 + dd) * 32 * 128)); } while (0)
#define QKCHAIN() do { if (NEGM) { __builtin_amdgcn_s_setprio(1); p = __builtin_amdgcn_mfma_f32_32x32x16_bf16(kf[0], qr[0], negm, 0, 0, 0); _Pragma("unroll") for (int d0 = 1; d0 < 4; ++d0) p = __builtin_amdgcn_mfma_f32_32x32x16_bf16(kf[d0], qr[d0], p, 0, 0, 0); __builtin_amdgcn_s_setprio(0); } \
        else { const float ci_ = cb - mhat; _Pragma("unroll") for (int r = 0; r < 16; ++r) p[r] = ci_; __builtin_amdgcn_s_setprio(1); _Pragma("unroll") for (int d0 = 0; d0 < 4; ++d0) p = __builtin_amdgcn_mfma_f32_32x32x16_bf16(kf[d0], qr[d0], p, 0, 0, 0); __builtin_amdgcn_s_setprio(0); } } while (0)
#define PVGROUP(VF, DP) do { __builtin_amdgcn_s_setprio(1); _Pragma("unroll") for (int dd = 0; dd < 2; ++dd) _Pragma("unroll") for (int jj = 0; jj < 2; ++jj) \
            o[2 * (DP) + dd] = __builtin_amdgcn_mfma_f32_32x32x16_bf16(__builtin_bit_cast(bf16x8, pw[jj]), __builtin_bit_cast(bf16x8, VF[dd][jj]), o[2 * (DP) + dd], 0, 0, 0); __builtin_amdgcn_s_setprio(0); } while (0)
#define TILE(PAR, t) do { \
        _Pragma("unroll") for (int i = 0; i < KP; ++i) *(LAS u32x4*)(kdst + ((PAR) * BUF + i * KDSTEP)) = kreg[i]; \
        _Pragma("unroll") for (int i = 0; i < VP; ++i) { *(LAS u32x2*)(vdst0 + ((PAR) * BUF + i * VDSTEP)) = (u32x2){vreg[i].x, vreg[i].y}; *(LAS u32x2*)(vdst1 + ((PAR) * BUF + i * VDSTEP)) = (u32x2){vreg[i].z, vreg[i].w}; } \
        __syncthreads(); \
        if ((t) + 1 < NT) { const bf16* kn = ksrc + (size_t)((t) + 1) * 64 * ZLD; const bf16* vn_ = vsrc + ((t) + 1) * 64; \
            _Pragma("unroll") for (int i = 0; i < KP; ++i) kreg[i] = *(const GAS u32x4*)(kn + (size_t)((NTHR / KPR) * i) * ZLD); \
            _Pragma("unroll") for (int i = 0; i < VP; ++i) vreg[i] = *(const GAS u32x4*)(vn_ + (size_t)(64 * i) * (size_t)N); } \
        const int k0 = (t) * 64; bool near = false; \
        if (BIAS) { const int relmax = k0 + 63 - qpos0, relmin = k0 - (qpos0 + 31); const int st_ = relmax <= -128 ? 0 : (relmin >= 128 ? 2 : 1); near = st_ == 1; \
            cb = st_ == 0 ? cbl : (st_ == 2 ? cbr : 0.f); } \
        bf16x8 kf[4]; u32x4 vfa[2][2]; f32x16 p; \
        LDK(PAR, 0); QKCHAIN(); \
        __builtin_amdgcn_sched_barrier(0); \
        _Pragma("unroll") for (int kb = 0; kb < 2; ++kb) { \
            if (kb == 0) LDK(PAR, 1); \
            LDV(vfa, PAR, 0, kb); \
            __builtin_amdgcn_sched_barrier(0); \
            if (BIAS && near) { const LAS float* bt = btq + (k0 + 32 * kb); _Pragma("unroll") for (int r = 0; r < 16; ++r) p[r] += bt[(r & 3) + 8 * (r >> 2)]; } \
            float rm = fmaxf(p[0], p[1]); \
            _Pragma("unroll") for (int r = 2; r < 16; ++r) rm = fmaxf(rm, p[r]); \
            rm = xmax32(rm); \
            const bool first = ((t) == 0) && (kb == 0); \
            if (first || __any(rm > THR)) { \
                const float dl = first ? rm : fmaxf(rm, 0.f); \
                mhat += dl; \
                _Pragma("unroll") for (int r = 0; r < 16; ++r) p[r] -= dl; \
                if (NEGM) { const float nm_ = -mhat; _Pragma("unroll") for (int r = 0; r < 16; ++r) negm[r] = nm_; } \
                if (!first) { \
                    const float f = __builtin_amdgcn_exp2f(-dl); l *= f; \
                    wsf[r32] = f; \
                    _Pragma("unroll") for (int r = 0; r < 16; ++r) { const float fr = wsf[crow(r, hi)]; \
                        _Pragma("unroll") for (int d = 0; d < DV / 32; ++d) o[d][r] *= fr; } \
                } \
            } \
            _Pragma("unroll") for (int r = 0; r < 16; ++r) p[r] = __builtin_amdgcn_exp2f(p[r]); \
            { f32x2 s2 = (f32x2){p[0], p[1]}; _Pragma("unroll") for (int r = 2; r < 16; r += 2) s2 += (f32x2){p[r], p[r + 1]}; l += s2.x + s2.y; } \
            u32x4 pw[2]; \
            _Pragma("unroll") for (int e = 0; e < 4; ++e) { pw[0][e] = cvtpk(p[2 * e], p[2 * e + 1]); pw[1][e] = cvtpk(p[8 + 2 * e], p[8 + 2 * e + 1]); } \
            __builtin_amdgcn_sched_barrier(0); \
            if (kb == 0) QKCHAIN(); \
            PVGROUP(vfa, 0); \
            if (DV == 128) { LDV(vfa, PAR, 1, kb); PVGROUP(vfa, 1); } \
            __builtin_amdgcn_sched_barrier(0); \
        } \
    } while (0)

    for (int t = 0; t < NT; t += 2) { TILE(0, t); TILE(1, t + 1); }
#undef TILE
#undef PVGROUP
#undef QKCHAIN
#undef LDK
#undef LDV
    l = xsum32(l);
    wsf[r32] = 1.f / l;
#pragma unroll
    for (int r = 0; r < 16; ++r) { const float fr = wsf[crow(r, hi)];
#pragma unroll
        for (int d = 0; d < DV / 32; ++d) o[d][r] *= fr; }
}


__device__ __forceinline__ void attn_core_gqa2(LAS unsigned char* lds, const bf16* __restrict__ Qw, const bf16* __restrict__ Kg, const bf16* __restrict__ Vtg,
                                               int N, f32x16 (&o)[2][2], const int wave_s) {
    const int tid = my_tid(wave_s);
    const int lane = tid & 63, r32 = lane & 31, hi = lane >> 5;
    constexpr int KW = 64, KBYTES = 64 * KW * 2, BUF = KBYTES + 64 * 128;
    constexpr float THR = 8.f;
    const int NT = N / 64;
    const int krow = tid >> 3, kch = tid & 7, vrow = tid >> 3, vch = tid & 7;
    LAS unsigned char* const kdst = lds + krow * 128 + ((kch ^ ((krow >> 1) & 7)) * 16);
    const int vsx = (vrow >> 1) & 7;
    LAS unsigned char* const vdst0 = lds + KBYTES + vrow * 128 + (((vch & ~1) ^ vsx) * 16) + (vch & 1) * 8;
    LAS unsigned char* const vdst1 = lds + KBYTES + vrow * 128 + (((vch | 1) ^ vsx) * 16) + (vch & 1) * 8;
    const bf16* ksrc = Kg + (size_t)krow * ZLD + kch * 8;
    const bf16* vsrc = Vtg + (size_t)vrow * (size_t)N + vch * 8;
    u32x4 kreg = *(const GAS u32x4*)ksrc, vreg = *(const GAS u32x4*)vsrc;
    bf16x8 qr[2][4];
#pragma unroll
    for (int h = 0; h < 2; ++h)
#pragma unroll
        for (int d0 = 0; d0 < 4; ++d0) qr[h][d0] = *(const GAS bf16x8*)(Qw + (size_t)r32 * ZLD + h * 64 + d0 * 16 + hi * 8);
    LAS float* wsf = (LAS float*)(lds + WSF_OFF) + (tid >> 6) * 32;
    const LAS unsigned char* kaddr[4]; const LAS unsigned char* vaddr[4];
#pragma unroll
    for (int d0 = 0; d0 < 4; ++d0) kaddr[d0] = lds + r32 * 128 + (((2 * d0 + hi) ^ ((r32 >> 1) & 7)) * 16);
#pragma unroll
    for (int j = 0; j < 4; ++j) vaddr[j] = lds + KBYTES + r32 * 128 + (((2 * j + hi) ^ ((r32 >> 1) & 7)) * 16);
    float mhat[2] = {0.f, 0.f}, l[2] = {0.f, 0.f};
#pragma unroll
    for (int h = 0; h < 2; ++h) { o[h][0] = f32x16{}; o[h][1] = f32x16{}; }
    bf16x8 kf[4]; u32x4 vfa[2][2]; f32x16 p[2]; u32x4 pw[2][2];
#define LDK2(PAR, KB) do { _Pragma("unroll") for (int d0 = 0; d0 < 4; ++d0) kf[d0] = *(const LAS bf16x8*)(kaddr[d0] + ((PAR) * BUF + (KB) * 32 * KW * 2)); } while (0)
#define LDV2(PAR, KB) do { _Pragma("unroll") for (int dd = 0; dd < 2; ++dd) _Pragma("unroll") for (int jj = 0; jj < 2; ++jj) vfa[dd][jj] = *(const LAS u32x4*)(vaddr[2 * (KB) + jj] + ((PAR) * BUF + dd * 32 * 128)); } while (0)
#define QK2() do { _Pragma("unroll") for (int h = 0; h < 2; ++h) { const float nm_ = -mhat[h]; _Pragma("unroll") for (int r = 0; r < 16; ++r) p[h][r] = nm_; } \
        __builtin_amdgcn_s_setprio(1); _Pragma("unroll") for (int h = 0; h < 2; ++h) { \
        _Pragma("unroll") for (int d0 = 0; d0 < 4; ++d0) p[h] = __builtin_amdgcn_mfma_f32_32x32x16_bf16(kf[d0], qr[h][d0], p[h], 0, 0, 0); } __builtin_amdgcn_s_setprio(0); } while (0)
#define SM2(h, FIRST) do { \
        float rm = fmaxf(p[h][0], p[h][1]); \
        _Pragma("unroll") for (int r = 2; r < 16; ++r) rm = fmaxf(rm, p[h][r]); \
        rm = xmax32(rm); \
        const bool first = (FIRST); \
        if (first || __any(rm > THR)) { \
            const float dl = first ? rm : fmaxf(rm, 0.f); \
            mhat[h] += dl; \
            _Pragma("unroll") for (int r = 0; r < 16; ++r) p[h][r] -= dl; \
            if (!first) { \
                const float f = __builtin_amdgcn_exp2f(-dl); l[h] *= f; \
                wsf[r32] = f; \
                _Pragma("unroll") for (int r = 0; r < 16; ++r) { const float fr = wsf[crow(r, hi)]; o[h][0][r] *= fr; o[h][1][r] *= fr; } \
            } \
        } \
        _Pragma("unroll") for (int r = 0; r < 16; ++r) p[h][r] = __builtin_amdgcn_exp2f(p[h][r]); \
        { f32x2 s2 = (f32x2){p[h][0], p[h][1]}; _Pragma("unroll") for (int r = 2; r < 16; r += 2) s2 += (f32x2){p[h][r], p[h][r + 1]}; l[h] += s2.x + s2.y; } \
        _Pragma("unroll") for (int e = 0; e < 4; ++e) { pw[h][0][e] = cvtpk(p[h][2 * e], p[h][2 * e + 1]); pw[h][1][e] = cvtpk(p[h][8 + 2 * e], p[h][8 + 2 * e + 1]); } \
    } while (0)
#define PV2() do { __builtin_amdgcn_s_setprio(1); _Pragma("unroll") for (int h = 0; h < 2; ++h) _Pragma("unroll") for (int dd = 0; dd < 2; ++dd) _Pragma("unroll") for (int jj = 0; jj < 2; ++jj) \
        o[h][dd] = __builtin_amdgcn_mfma_f32_32x32x16_bf16(__builtin_bit_cast(bf16x8, pw[h][jj]), __builtin_bit_cast(bf16x8, vfa[dd][jj]), o[h][dd], 0, 0, 0); __builtin_amdgcn_s_setprio(0); } while (0)
#define TILE2(PAR, t) do { \
        *(LAS u32x4*)(kdst + (PAR) * BUF) = kreg; \
        *(LAS u32x2*)(vdst0 + (PAR) * BUF) = (u32x2){vreg.x, vreg.y}; *(LAS u32x2*)(vdst1 + (PAR) * BUF) = (u32x2){vreg.z, vreg.w}; \
        __syncthreads(); \
        if ((t) + 1 < NT) { kreg = *(const GAS u32x4*)(ksrc + (size_t)((t) + 1) * 64 * ZLD); vreg = *(const GAS u32x4*)(vsrc + ((t) + 1) * 64); } \
        LDK2(PAR, 0); QK2(); \
        __builtin_amdgcn_sched_barrier(0); \
        LDK2(PAR, 1); LDV2(PAR, 0); \
        __builtin_amdgcn_sched_barrier(0); \
        SM2(0, (t) == 0); SM2(1, (t) == 0); \
        __builtin_amdgcn_sched_barrier(0); \
        QK2(); PV2(); \
        __builtin_amdgcn_sched_barrier(0); \
        LDV2(PAR, 1); \
        __builtin_amdgcn_sched_barrier(0); \
        SM2(0, false); SM2(1, false); \
        __builtin_amdgcn_sched_barrier(0); \
        PV2(); \
        __builtin_amdgcn_sched_barrier(0); \
    } while (0)
    for (int t = 0; t < NT; t += 2) { TILE2(0, t); TILE2(1, t + 1); }
#undef TILE2
#undef PV2
#undef SM2
#undef QK2
#undef LDV2
#undef LDK2
#pragma unroll
    for (int h = 0; h < 2; ++h) {
        const float lt = xsum32(l[h]);
        wsf[r32] = 1.f / lt;
#pragma unroll
        for (int r = 0; r < 16; ++r) { const float fr = wsf[crow(r, hi)]; o[h][0][r] *= fr; o[h][1][r] *= fr; }
    }
}

constexpr int NUNITS = 192;
__device__ __forceinline__ void attn_unit_diff(int xq, int u, LAS unsigned char* lds, const bf16* Z, const bf16* VtA, bf16* OAB, const LAS float* btabs, const LAS float* lamL, const int layer, const float* subg, const int wave) {
    const int tid = my_tid(wave);
    const int lane = tid & 63, r32 = lane & 31, hi = lane >> 5;
    int N, tok0, hd, qb;
    if (u < 128) { N = NP; const int grp = xq + 8 * (u >> 6); tok0 = (grp >> 2) * NP; hd = grp & 3; qb = u & 63; }
    else         { N = NS; const int v = u - 128, grp = xq + 8 * (v >> 5); tok0 = MC_P + (grp >> 2) * NS; hd = grp & 3; qb = v & 31; }
    const int qg = wave >> 1, c = wave & 1, q0w = qb * 128 + qg * 32;
    const bf16* Qw = Z + (size_t)(tok0 + q0w) * ZLD + hd * 128 + c * 64;
    const bf16* Kg = Z + (size_t)tok0 * ZLD + 512 + hd * 128;
    const bf16* Vt = VtA + (size_t)tok0 * 512 + (size_t)(hd * 128) * N;
    f32x16 o[4];
    attn_core<128, 128, true>(lds, Qw, Kg, Vt, N, c * 64, q0w, btabs + hd * BT_N, o, wave);
    LAS float* ex = (LAS float*)(lds + 65536) + qg * 4096;
    if (c == 1) {
#pragma unroll
        for (int r = 0; r < 16; ++r)
#pragma unroll
            for (int d = 0; d < 4; ++d) ex[crow(r, hi) * 128 + d * 32 + r32] = o[d][r];
    }
    __syncthreads();
    if (c == 0) {
        const float lam = lamL[layer], lam_init = layer == 0 ? 0.2f : 0.35550934f;
        float gsc[4];
#pragma unroll
        for (int d = 0; d < 4; ++d) gsc[d] = subg[d * 32 + r32] * (1.f - lam_init);
        bf16* Ow = OAB + (size_t)(tok0 + q0w) * DM + hd * 128;
#pragma unroll
        for (int r = 0; r < 16; ++r) {
            float v[4]; float ss = 0.f;
#pragma unroll
            for (int d = 0; d < 4; ++d) { v[d] = o[d][r] - lam * ex[crow(r, hi) * 128 + d * 32 + r32]; ss += v[d] * v[d]; }
            ss = half_sum(ss, lane);
            const float rstd = 1.f / sqrtf(ss * (1.f / 128.f) + 1e-5f);
#pragma unroll
            for (int d = 0; d < 4; ++d) Ow[(size_t)crow(r, hi) * DM + d * 32 + r32] = f2bf(v[d] * rstd * gsc[d]);
        }
    }
}
__device__ __forceinline__ void attn_unit_gqa(int xq, int u, LAS unsigned char* lds, const bf16* Z, const bf16* VtB, bf16* OAB, const LAS float* btabs, const int wave) {
    const int tid = my_tid(wave);
    const int lane = tid & 63, r32 = lane & 31, hi = lane >> 5;
    int N, tok0, qb; const int hd = xq & 1;
    if (u < 64) { N = NP; tok0 = (xq >> 1) * NP; qb = u; }
    else        { N = NS; tok0 = MC_P + (xq >> 1) * NS; qb = u - 64; }
    const int hp = wave >> 2, rg = wave & 3, q0w = qb * 128 + rg * 32;
    const bf16* Qw = Z + (size_t)(tok0 + q0w) * ZLD + 1536 + hd * 256 + hp * 128;
    const bf16* Kg = Z + (size_t)tok0 * ZLD + 2048 + hd * 64;
    const bf16* Vt = VtB + (size_t)tok0 * 128 + (size_t)(hd * 64) * N;
    f32x16 o[2][2];
    attn_core_gqa2(lds, Qw, Kg, Vt, N, o, wave);
#pragma unroll
    for (int h = 0; h < 2; ++h) {
        bf16* Ow = OAB + (size_t)(tok0 + q0w) * DM + 512 + (hd * 4 + hp * 2 + h) * 64;
#pragma unroll
        for (int r = 0; r < 16; ++r)
#pragma unroll
            for (int d = 0; d < 2; ++d) Ow[(size_t)crow(r, hi) * DM + d * 32 + r32] = f2bf(o[h][d][r]);
    }
    (void)btabs;
}

#define XB_TMO      128
#define XB_XCNT(j)  (256  + 64 * (j))
#define XB_XSUB(j)  (1280 + 64 * (j))
#define XB_XGEN(j)  (2304 + 64 * (j))
#define XB_TOP      3328
#define XB_TOPGEN   3392
#define XCD_BAR_WORDS 3456
#define XB_SPIN_CAP (1u << 18)

__device__ __forceinline__ unsigned xb_ld(unsigned* p)              { return __hip_atomic_load(p, __ATOMIC_RELAXED, __HIP_MEMORY_SCOPE_AGENT); }
__device__ __forceinline__ unsigned xb_add(unsigned* p, unsigned v) { return __hip_atomic_fetch_add(p, v, __ATOMIC_RELAXED, __HIP_MEMORY_SCOPE_AGENT); }
__device__ __forceinline__ unsigned xb_xcc_id() { return (unsigned)__builtin_amdgcn_s_getreg((3 << 11) | 20) & 0xFu; }
#define XB_SPIN(cond, bar) do { unsigned _sp = 0; while (cond) { __builtin_amdgcn_s_sleep(1); \
    if ((++_sp & 255u) == 0u) { if (xb_ld(&(bar)[XB_TMO])) break; if (_sp > XB_SPIN_CAP) { atomicAdd(&(bar)[XB_TMO], 1u); break; } } } } while (0)

struct XcdBarrier {
    unsigned* bar; unsigned x;
    volatile LAS unsigned* st;
};

__device__ __forceinline__ XcdBarrier xcd_barrier_post(unsigned* bar, volatile LAS unsigned* st, bool leader) {
    XcdBarrier b; b.bar = bar; b.x = xb_xcc_id(); b.st = st;
    if (leader) (void)xb_add(&bar[XB_XCNT(b.x)], 1u);
    return b;
}
__device__ __forceinline__ void xcd_barrier_complete(unsigned* bar, unsigned x, unsigned& nloc, unsigned& nx) {
    const unsigned G = gridDim.x * gridDim.y * gridDim.z;
    unsigned sum, cnt, mine, sp = 0u;
    for (;;) {
        sum = 0u; cnt = 0u; mine = 0u;
#pragma unroll
        for (unsigned j = 0; j < 16; ++j) { const unsigned c = xb_ld(&bar[XB_XCNT(j)]); sum += c; cnt += (c > 0u) ? 1u : 0u; mine = (j == x) ? c : mine; }
        if (sum == G) break;
        __builtin_amdgcn_s_sleep(1);
        if ((++sp & 255u) == 0u) { if (xb_ld(&bar[XB_TMO])) break; if (sp > XB_SPIN_CAP) { atomicAdd(&bar[XB_TMO], 1u); break; } }
    }
    nloc = mine > 0u ? mine : 1u; nx = cnt > 0u ? cnt : 1u;
}

__device__ __forceinline__ void xcd_barrier(const XcdBarrier& b, bool leader) {
    asm volatile("s_waitcnt vmcnt(0)" ::: "memory");
    __syncthreads();
    if (leader) {
        unsigned* bar = b.bar;
        __builtin_amdgcn_s_waitcnt(0);
        unsigned nloc = b.st[0], nx = b.st[1];
        if (nloc == 0u) { xcd_barrier_complete(bar, b.x, nloc, nx); b.st[0] = nloc; b.st[1] = nx; }
        const unsigned old = xb_add(&bar[XB_XSUB(b.x)], 1u);
        const unsigned gen = old / nloc;
        if (old + 1u == (gen + 1u) * nloc) {
            __builtin_amdgcn_fence(__ATOMIC_RELEASE, "agent");
            asm volatile("s_waitcnt vmcnt(0)" ::: "memory");
            const unsigned og = xb_add(&bar[XB_TOP], 1u);
            const unsigned tg = og / nx;
            if (og + 1u == (tg + 1u) * nx) xb_add(&bar[XB_TOPGEN], 1u);
            else XB_SPIN(xb_ld(&bar[XB_TOPGEN]) == tg, bar);
            __builtin_amdgcn_fence(__ATOMIC_ACQUIRE, "agent");
            xb_add(&bar[XB_XGEN(b.x)], 1u);
            asm volatile("s_waitcnt vmcnt(0)" ::: "memory");
        } else {
            XB_SPIN(xb_ld(&bar[XB_XGEN(b.x)]) == gen, bar);
            __builtin_amdgcn_fence(__ATOMIC_ACQUIRE, "agent");
            asm volatile("s_waitcnt vmcnt(0)" ::: "memory");
        }
    }
    __syncthreads();
}

__device__ __forceinline__ unsigned long long ldptr(LAS unsigned char* lds, int k) {
    int z = 0; asm volatile("" : "+v"(z));
    const unsigned long long v = ((volatile LAS unsigned long long*)(lds + PTAB_OFF + z))[k];
    const unsigned lo = __builtin_amdgcn_readfirstlane((unsigned)v), hi = __builtin_amdgcn_readfirstlane((unsigned)(v >> 32));
    return ((unsigned long long)hi << 32) | lo;
}
__device__ __forceinline__ int t5_bucket(int rel) {
    const int ret = rel > 0 ? 16 : 0; const int n = rel < 0 ? -rel : rel;
    const float nf = (float)(n > 1 ? n : 1);
    int large = 8 + (int)(logf(nf / 8.f) / 2.772588722239781f * 8.f);
    large = large < 15 ? large : 15;
    return ret + (n < 8 ? n : large);
}

__global__ void __launch_bounds__(NTHR, 2) fwd_megakernel(Params P) {
    extern __shared__ __attribute__((aligned(16))) unsigned char lds_raw[];
    LAS unsigned char* lds = (LAS unsigned char*)lds_raw;
    cg::grid_group grid = cg::this_grid();
    int tid = threadIdx.x, lane = tid & 63; const int wave = __builtin_amdgcn_readfirstlane(tid >> 6);
    const int G = gridDim.x, bid = blockIdx.x;
    grid.sync();
    if (tid < 4) ((volatile LAS unsigned*)(lds + MISC_OFF + 32))[tid] = 0u;
    __syncthreads();
    (void)xcd_barrier_post((unsigned*)(P.ws + WS_CTL) + 12288, (volatile LAS unsigned*)(lds + MISC_OFF + 32), tid == 0);
#define GRID_SYNC() do { XcdBarrier b_; b_.bar = (unsigned*)(WSP + WS_CTL) + 12288; b_.x = xb_xcc_id(); b_.st = (volatile LAS unsigned*)(lds + MISC_OFF + 32); xcd_barrier(b_, my_tid(wave) == 0); } while (0)
    const int gw = bid * NWAVES + wave, NGW = G * NWAVES;
    if (tid < 20) ((LAS unsigned long long*)(lds + PTAB_OFF))[tid] = (unsigned long long)P.in[tid];
    if (tid == 20) ((LAS unsigned long long*)(lds + PTAB_OFF))[20] = (unsigned long long)P.out;
    if (tid == 21) ((LAS unsigned long long*)(lds + PTAB_OFF))[21] = (unsigned long long)P.ws;
    __syncthreads();
#define INP(k) ((const float*)ldptr(lds, (k)))
#define OUTP ((float*)ldptr(lds, 20))
#define WSP ((unsigned char*)ldptr(lds, 21))
    volatile LAS unsigned* slot = (volatile LAS unsigned*)(lds + MISC_OFF);
    LAS float* lamL = (LAS float*)(lds + MISC_OFF + 16);
    LAS float* btabs = (LAS float*)(lds + MISC_OFF + 64);
#define X_PROMPT INP(0)
#define X_SAMPLE INP(1)
#define WS_BF(off) ((bf16*)(WSP + (off)))

    { const float* t5 = INP(2);
      for (int i = tid; i < 4 * BT_N; i += NTHR) { const int h = i / BT_N, rel = min(max((i % BT_N) - 256, -128), 128); btabs[i] = t5[t5_bucket(rel) * 4 + h] * LOG2E; } }
    if (wave == 0) {
        const float* lq1 = INP(6); const float* lk1 = INP(7); const float* lq2 = INP(8); const float* lk2 = INP(9);
        for (int l = 0; l < 2; ++l) {
            const float s1 = wave_sum(lq1[l * 64 + lane] * lk1[l * 64 + lane], lane), s2 = wave_sum(lq2[l * 64 + lane] * lk2[l * 64 + lane], lane);
            const float lam_init = 0.8f - 0.6f * expf(-0.3f * (float)l);
            if (lane == 0) lamL[l] = expf(s1) - expf(s2) + lam_init;
        }
    }
    __syncthreads();

    {
        LAS float* scr = (LAS float*)(lds + wave * 16384);
        constexpr int I_IN = (DM / 64) * (INC / 32), I_UA = (512 / 64) * (DM / 32), I_O = (DM / 64) * (DM / 32), I_1 = (DM / 64) * (DFF / 32), I_2 = (DFF / 64) * (DM / 32);
        constexpr int PER_L = I_IN + 2 * I_UA + I_O + I_1 + I_2;
        for (int it = gw; it < 2 * PER_L; it += NGW) {
            const int l = it / PER_L; int r = it % PER_L;
            if (r < I_IN) { p0_transpose_item(INP(4) + (size_t)l * DM * INC, DM, INC, WS_BF(WS_WIN) + (size_t)l * INC * DM, scr, r, lane); continue; } r -= I_IN;
            if (r < I_UA) { p0_transpose_item(INP(13) + (size_t)l * 512 * DM, 512, DM, WS_BF(WS_WUA) + (size_t)l * DM * 512, scr, r, lane); continue; } r -= I_UA;
            if (r < I_UA) { p0_transpose_item(INP(14) + (size_t)l * 512 * DM, 512, DM, WS_BF(WS_WUB) + (size_t)l * DM * 512, scr, r, lane); continue; } r -= I_UA;
            if (r < I_O)  { p0_transpose_item(INP(15) + (size_t)l * DM * DM, DM, DM, WS_BF(WS_WO) + (size_t)l * DM * DM, scr, r, lane); continue; } r -= I_O;
            if (r < I_1)  { p0_transpose_item(INP(17) + (size_t)l * DM * DFF, DM, DFF, WS_BF(WS_W1) + (size_t)l * DFF * DM, scr, r, lane); continue; } r -= I_1;
            p0_transpose_item(INP(18) + (size_t)l * DFF * DM, DFF, DM, WS_BF(WS_W2) + (size_t)l * DM * DFF, scr, r, lane);
        }
    }

    for (int chunk = 0; chunk < 2; ++chunk) {
        const int prow0 = chunk * MC_P, srow0 = MPROMPT + chunk * 16384;
        for (int layer = 0; layer < 2; ++layer) {
            tid = my_tid(wave); lane = tid & 63;
            {
                const float* xP = layer == 0 ? X_PROMPT : OUTP;
                const float* xS = layer == 0 ? X_SAMPLE : OUTP + (size_t)MPROMPT * DM;
                const float* gn = INP(3) + layer * DM; bf16* Hb = WS_BF(WS_H);
                int m = gw;
                do {
                    const float* xr = m < MC_P ? xP + (size_t)(prow0 + m) * DM : xS + (size_t)(srow0 - MPROMPT + (m - MC_P)) * DM;
                    const int m2 = m + NGW;
                    if (m2 < MC) { const float* xr2 = m2 < MC_P ? xP + (size_t)(prow0 + m2) * DM : xS + (size_t)(srow0 - MPROMPT + (m2 - MC_P)) * DM;
                        rms_row2_to_bf16(xr, xr2, gn, Hb + (size_t)m * DM, Hb + (size_t)m2 * DM, lane); }
                    else rms_row_to_bf16(xr, gn, Hb + (size_t)m * DM, lane);
                    m += 2 * NGW;
                } while (m < MC);
            }
            GRID_SYNC();
            {
                pg8::Gemm g{WS_BF(WS_H), WS_BF(WS_WIN) + (size_t)layer * INC * DM, MC, INC, DM, DM, DM}; pg8::StaticOrder S; S.init(MC, INC, G, bid);
                pg8::EpiInProj E{WS_BF(WS_Z), WS_BF(WS_G), INP(5) + layer * GLD, C2};
                pg8::gemm_phase<pg8::EpiInProj, pg8::StaticOrder, true, true>(lds, g, S, E, wave);
            }
            GRID_SYNC();
            tid = my_tid(wave); lane = tid & 63;
            {
                bf16* Zb = WS_BF(WS_Z); bf16* VtA = WS_BF(WS_VTA); bf16* VtB = WS_BF(WS_VTB); const float* gq = INP(11) + layer * 64; const float* gk = INP(12) + layer * 64;
                for (int tile = bid; tile < MC / 64; tile += G) {
                    const int m0 = tile * 64; int tok0, N;
                    if (m0 < MC_P) { N = NP; tok0 = (m0 / NP) * NP; } else { N = NS; tok0 = MC_P + ((m0 - MC_P) / NS) * NS; }
                    prepass_tile(Zb, VtA, VtB, gq, gk, m0, tok0, N, lds, wave, lane);
                }
            }
            GRID_SYNC();
            {
                const bf16* Zb = WS_BF(WS_Z); const bf16* VtA = WS_BF(WS_VTA); bf16* OAB = WS_BF(WS_OAB); const float* sg = INP(10) + layer * 128;
                const int x0 = (int)(xb_xcc_id() & 7u);
                for (int xx = 0; xx < 8; ++xx) {
                    const int xq = (x0 + xx) & 7;
                    unsigned* ctr = (unsigned*)(WSP + WS_CTL) + (((chunk * 2 + layer) * 2) * 8 + xq) * 64;
                    for (;;) {
                        if (my_tid(wave) == 0) slot[0] = atomicAdd(ctr, 1u);
                        __syncthreads();
                        const int u = (int)slot[0];
                        if (u >= NUNITS) break;
                        attn_unit_diff(xq, u, lds, Zb, VtA, OAB, btabs, lamL, layer, sg, wave);
                    }
                    __syncthreads();
                }
            }
            {
                const bf16* Zb = WS_BF(WS_Z); const bf16* VtB = WS_BF(WS_VTB); bf16* OAB = WS_BF(WS_OAB);
                const int x0 = (int)(xb_xcc_id() & 7u);
                for (int xx = 0; xx < 8; ++xx) {
                    const int xq = (x0 + xx) & 7;
                    unsigned* ctr = (unsigned*)(WSP + WS_CTL) + (((chunk * 2 + layer) * 2 + 1) * 8 + xq) * 64;
                    for (;;) {
                        if (my_tid(wave) == 0) slot[0] = atomicAdd(ctr, 1u);
                        __syncthreads();
                        const int u = (int)slot[0];
                        if (u >= 96) break;
                        attn_unit_gqa(xq, u, lds, Zb, VtB, OAB, btabs, wave);
                    }
                    __syncthreads();
                }
            }
            GRID_SYNC();
            {
                pg8::Gemm g{WS_BF(WS_OAB), WS_BF(WS_WUA) + (size_t)layer * DM * 512, MC, DM, 512, DM, 512}; pg8::StaticOrder S; S.init(MC, DM, G, bid);
                pg8::EpiGate<false> E{WS_BF(WS_U), WS_BF(WS_G), 0};
                pg8::gemm_phase<pg8::EpiGate<false>, pg8::StaticOrder, true, true>(lds, g, S, E, wave);
            }
            {
                pg8::Gemm g{WS_BF(WS_OAB) + 512, WS_BF(WS_WUB) + (size_t)layer * DM * 512, MC, DM, 512, DM, 512}; pg8::StaticOrder S; S.init(MC, DM, G, bid);
                pg8::EpiGate<true> E{WS_BF(WS_U), WS_BF(WS_G), 1024};
                pg8::gemm_phase<pg8::EpiGate<true>, pg8::StaticOrder, true, true>(lds, g, S, E, wave);
            }
            GRID_SYNC();
            {
                const float* xP = layer == 0 ? X_PROMPT : OUTP;
                const float* xS = layer == 0 ? X_SAMPLE : OUTP + (size_t)MPROMPT * DM;
                pg8::Gemm g{WS_BF(WS_U), WS_BF(WS_WO) + (size_t)layer * DM * DM, MC, DM, DM, DM, DM}; pg8::StaticOrder S; S.init(MC, DM, G, bid);
                pg8::EpiResid E{xP, xS, OUTP, prow0, srow0};
                pg8::gemm_phase<pg8::EpiResid, pg8::StaticOrder, true, true>(lds, g, S, E, wave);
            }
            GRID_SYNC();
            tid = my_tid(wave); lane = tid & 63;
            {
                const float* xo = OUTP; const float* gn = INP(16) + layer * DM; bf16* Hb = WS_BF(WS_H);
                int m = gw;
                do {
                    const int grow = m < MC_P ? prow0 + m : srow0 + (m - MC_P);
                    const int m2 = m + NGW;
                    if (m2 < MC) { const int grow2 = m2 < MC_P ? prow0 + m2 : srow0 + (m2 - MC_P);
                        rms_row2_to_bf16(xo + (size_t)grow * DM, xo + (size_t)grow2 * DM, gn, Hb + (size_t)m * DM, Hb + (size_t)m2 * DM, lane); }
                    else rms_row_to_bf16(xo + (size_t)grow * DM, gn, Hb + (size_t)m * DM, lane);
                    m += 2 * NGW;
                } while (m < MC);
            }
            GRID_SYNC();
            {
                pg8::Gemm g{WS_BF(WS_H), WS_BF(WS_W1) + (size_t)layer * DFF * DM, MC, DFF, DM, DM, DM}; pg8::StaticOrder S; S.init(MC, DFF, G, bid);
                pg8::EpiRelu2 E{WS_BF(WS_ACT)};
                pg8::gemm_phase<pg8::EpiRelu2, pg8::StaticOrder, true, true>(lds, g, S, E, wave);
            }
            GRID_SYNC();
            {
                float* xo = OUTP;
                pg8::Gemm g{WS_BF(WS_ACT), WS_BF(WS_W2) + (size_t)layer * DM * DFF, MC, DM, DFF, DFF, DFF}; pg8::StaticOrder S; S.init(MC, DM, G, bid);
                pg8::EpiResid E{xo, xo + (size_t)MPROMPT * DM, xo, prow0, srow0};
                pg8::gemm_phase<pg8::EpiResid, pg8::StaticOrder, true, true>(lds, g, S, E, wave);
            }
            GRID_SYNC();
        }
    }
    tid = my_tid(wave); lane = tid & 63;
    { float* xo = OUTP; const float* gn = INP(19);
      int m = gw; do { rms_row_f32_inplace(xo + (size_t)m * DM, gn, lane); m += NGW; } while (m < MTOT); }
}

extern "C" void kernel_launch(void* const* d_in, const int* in_sizes, int n_in, void* d_out, int out_size, void* d_ws, size_t ws_size, hipStream_t stream) {
    static int grid = 0;
    if (grid == 0) {
        if (n_in != 20 || out_size != MTOT * DM || ws_size < WS_END) { fprintf(stderr, "kernel_launch: unexpected problem shape (n_in %d out %d ws %zu)\n", n_in, out_size, ws_size); grid = -1; return; }
        int dev = 0, cus = 0, per_cu = 0;
        hipGetDevice(&dev);
        hipDeviceGetAttribute(&cus, hipDeviceAttributeMultiprocessorCount, dev);
        hipFuncSetAttribute((const void*)fwd_megakernel, hipFuncAttributeMaxDynamicSharedMemorySize, LDS_BYTES);
        hipOccupancyMaxActiveBlocksPerMultiprocessor(&per_cu, (const void*)fwd_megakernel, NTHR, LDS_BYTES);
        if (per_cu < 1) per_cu = 1;
        grid = cus * per_cu;
        (void)hipGetLastError();
    }
    if (grid < 0) return;
    if (hipMemsetAsync((char*)d_ws + WS_CTL, 0, 65536, stream) != hipSuccess) { fprintf(stderr, "kernel_launch: memset failed\n"); return; }
    Params p{};
    for (int i = 0; i < 20; ++i) p.in[i] = (const float*)d_in[i];
    p.out = (float*)d_out; p.ws = (unsigned char*)d_ws;
    void* args[] = {&p};
    hipError_t e = hipLaunchCooperativeKernel((const void*)fwd_megakernel, dim3(grid), dim3(NTHR), args, LDS_BYTES, stream);
    if (e != hipSuccess) fprintf(stderr, "cooperative launch failed: %s (grid %d)\n", hipGetErrorString(e), grid);
}
```

```cpp
#include <hip/hip_runtime.h>
#include <hip/hip_cooperative_groups.h>
#include <cstdio>
#include <cstdint>
namespace cg = cooperative_groups;
namespace pg8 {
#define PG8_LAS __attribute__((address_space(3)))
typedef unsigned short bf16_t;
typedef short bf16x8 __attribute__((ext_vector_type(8)));
typedef float f32x4 __attribute__((ext_vector_type(4)));
typedef unsigned u32x4 __attribute__((ext_vector_type(4)));
constexpr int BM = 256, BK = 64, HALF = 128, HTB = HALF * BK * 2  , STAGE_BYTES = 8 * HTB, NXCD = 8, WGM = 8;

__host__ __device__ __forceinline__ int lds_byte(int r, int c) { const int st = (r >> 4) * 2 + (c >> 5), rr = r & 15, cc = c & 31, ob = rr * 64 + cc * 2; return st * 1024 + (ob ^ (((ob >> 9) & 1) << 5)); }
__host__ __device__ __forceinline__ void stage_rc(int b, int& R, int& C) { const int st = b / 1024, sb = b % 1024, swz = sb ^ (((sb >> 9) & 1) << 5); R = (st >> 1) * 16 + swz / 64; C = (st & 1) * 32 + (swz % 64) / 2; }
__host__ __device__ __forceinline__ int perm32(int rho) { const int n = rho >> 4, i = rho & 15; return 8 * (i >> 2) + 4 * n + (i & 3); }

struct Unit { int pm, pn; };
struct Gemm { const bf16_t* A; const bf16_t* Bt; int M, N, K, lda, ldb; };

struct StaticOrder {
    int nM, nN, nwg, G, c;
    __host__ __device__ void init(int M, int N, int G_, int c_) { nM = M / BM; nN = N / BM; nwg = nM * nN; G = G_; c = c_; }
    __host__ __device__ bool next(int i, Unit& u) const {
        const long L = (long)i * G + c; if (L >= nwg) return false;
        int wgid = (int)L; { const int q = nwg / NXCD, r = nwg % NXCD, xcd = wgid % NXCD, off = wgid / NXCD; wgid = (xcd < r ? xcd * (q + 1) : r * (q + 1) + (xcd - r) * q) + off; }
        const int nig = WGM * nN, gid = wgid / nig, fm = gid * WGM, gsz = (nM - fm) < WGM ? (nM - fm) : WGM;
        u.pm = fm + ((wgid % nig) % gsz); u.pn = (wgid % nig) / gsz; return true;
    }
    __device__ __forceinline__ void a_ready(const Unit&) const {}
    __device__ __forceinline__ void done(const Unit&) const {}
};


typedef float cvt_f32x2_t __attribute__((ext_vector_type(2))); typedef __bf16 cvt_bf16x2_t __attribute__((ext_vector_type(2)));
__device__ __forceinline__ unsigned cvt_pk_bf16(float lo, float hi) { cvt_f32x2_t v = {lo, hi}; cvt_bf16x2_t b = __builtin_convertvector(v, cvt_bf16x2_t); return __builtin_bit_cast(unsigned, b); }
__device__ __forceinline__ float bf_lo(unsigned w) { return __uint_as_float(w << 16); }
__device__ __forceinline__ float bf_hi(unsigned w) { return __uint_as_float(w & 0xffff0000u); }

struct EpiInProj {
    static constexpr bool PERM = true, AFTER_DRAIN = false;
    bf16_t* Z; bf16_t* G; const float* bgate; float qscale;
    __device__ __forceinline__ void operator()(const f32x4 (&acc)[2][2][4][2], const Unit& u, int wr, int wc, int fr, int fq) const {
        asm volatile("" : "+v"(fr), "+v"(fq));
        const int row0 = u.pm * BM + wr * 64 + fr; const int colw = wc * 32 + 8 * fq;
        if (u.pn < 9) {
            const float sc = (u.pn < 2) ? qscale : 1.f;
            bf16_t* base = Z + u.pn * BM + colw;
#pragma unroll
            for (int ai = 0; ai < 2; ++ai)
#pragma unroll
                for (int m = 0; m < 4; ++m) { bf16_t* rowp = base + (size_t)(row0 + ai * HALF + m * 16) * 2304;
#pragma unroll
                    for (int bj = 0; bj < 2; ++bj) { f32x4 v0 = acc[ai][bj][m][0] * sc, v1 = acc[ai][bj][m][1] * sc;
                        u32x4 w; w.x = cvt_pk_bf16(v0[0], v0[1]); w.y = cvt_pk_bf16(v0[2], v0[3]); w.z = cvt_pk_bf16(v1[0], v1[1]); w.w = cvt_pk_bf16(v1[2], v1[3]);
                        *(u32x4*)(rowp + bj * HALF) = w; } }
        } else {
            const int gc = (u.pn - 9) * BM + colw;
            bf16_t* base = G + gc;
            f32x4 bv[2][2];
#pragma unroll
            for (int bj = 0; bj < 2; ++bj)
#pragma unroll
                for (int n = 0; n < 2; ++n) bv[bj][n] = *(const f32x4*)(bgate + gc + bj * HALF + 4 * n);
#pragma unroll
            for (int ai = 0; ai < 2; ++ai)
#pragma unroll
                for (int m = 0; m < 4; ++m) { bf16_t* rowp = base + (size_t)(row0 + ai * HALF + m * 16) * 2048;
#pragma unroll
                    for (int bj = 0; bj < 2; ++bj) { f32x4 v0 = acc[ai][bj][m][0] + bv[bj][0], v1 = acc[ai][bj][m][1] + bv[bj][1];
#pragma unroll
                        for (int e = 0; e < 4; ++e) { v0[e] = __builtin_amdgcn_rcpf(1.f + __builtin_amdgcn_exp2f(-1.4426950408889634f * v0[e])); v1[e] = __builtin_amdgcn_rcpf(1.f + __builtin_amdgcn_exp2f(-1.4426950408889634f * v1[e])); }
                        u32x4 w; w.x = cvt_pk_bf16(v0[0], v0[1]); w.y = cvt_pk_bf16(v0[2], v0[3]); w.z = cvt_pk_bf16(v1[0], v1[1]); w.w = cvt_pk_bf16(v1[2], v1[3]);
                        *(u32x4*)(rowp + bj * HALF) = w; } }
        }
    }
};
template <bool ADD> struct EpiGate {
    static constexpr bool PERM = true, AFTER_DRAIN = false;
    bf16_t* U; const bf16_t* G; int goff;
    __device__ __forceinline__ void operator()(const f32x4 (&acc)[2][2][4][2], const Unit& u, int wr, int wc, int fr, int fq) const {
        asm volatile("" : "+v"(fr), "+v"(fq));
        const int row0 = u.pm * BM + wr * 64 + fr; const int col0 = u.pn * BM + wc * 32 + 8 * fq;
#pragma unroll
        for (int ai = 0; ai < 2; ++ai)
#pragma unroll
            for (int m = 0; m < 4; ++m) { const size_t r = (size_t)(row0 + ai * HALF + m * 16);
#pragma unroll
                for (int bj = 0; bj < 2; ++bj) {
                    const u32x4 g = *(const u32x4*)(G + r * 2048 + goff + col0 + bj * HALF);
                    f32x4 v0 = acc[ai][bj][m][0], v1 = acc[ai][bj][m][1];
                    v0[0] *= bf_lo(g.x); v0[1] *= bf_hi(g.x); v0[2] *= bf_lo(g.y); v0[3] *= bf_hi(g.y);
                    v1[0] *= bf_lo(g.z); v1[1] *= bf_hi(g.z); v1[2] *= bf_lo(g.w); v1[3] *= bf_hi(g.w);
                    bf16_t* op = U + r * 1024 + col0 + bj * HALF;
                    if (ADD) { const u32x4 p = *(const u32x4*)op;
                        v0[0] += bf_lo(p.x); v0[1] += bf_hi(p.x); v0[2] += bf_lo(p.y); v0[3] += bf_hi(p.y);
                        v1[0] += bf_lo(p.z); v1[1] += bf_hi(p.z); v1[2] += bf_lo(p.w); v1[3] += bf_hi(p.w); }
                    u32x4 w; w.x = cvt_pk_bf16(v0[0], v0[1]); w.y = cvt_pk_bf16(v0[2], v0[3]); w.z = cvt_pk_bf16(v1[0], v1[1]); w.w = cvt_pk_bf16(v1[2], v1[3]);
                    *(u32x4*)op = w; }
                asm volatile("" ::: "memory"); }
    }
};
struct EpiRelu2 {
    static constexpr bool PERM = true, AFTER_DRAIN = false;
    bf16_t* O;
    __device__ __forceinline__ void operator()(const f32x4 (&acc)[2][2][4][2], const Unit& u, int wr, int wc, int fr, int fq) const {
        asm volatile("" : "+v"(fr), "+v"(fq));
        const int row0 = u.pm * BM + wr * 64 + fr; const int col0 = u.pn * BM + wc * 32 + 8 * fq;
#pragma unroll
        for (int ai = 0; ai < 2; ++ai)
#pragma unroll
            for (int m = 0; m < 4; ++m) { bf16_t* rowp = O + (size_t)(row0 + ai * HALF + m * 16) * 4096 + col0;
#pragma unroll
                for (int bj = 0; bj < 2; ++bj) { f32x4 v0 = acc[ai][bj][m][0], v1 = acc[ai][bj][m][1];
#pragma unroll
                    for (int e = 0; e < 4; ++e) { const float a = fmaxf(v0[e], 0.f), b = fmaxf(v1[e], 0.f); v0[e] = a * a; v1[e] = b * b; }
                    u32x4 w; w.x = cvt_pk_bf16(v0[0], v0[1]); w.y = cvt_pk_bf16(v0[2], v0[3]); w.z = cvt_pk_bf16(v1[0], v1[1]); w.w = cvt_pk_bf16(v1[2], v1[3]);
                    *(u32x4*)(rowp + bj * HALF) = w; } }
    }
};
struct EpiResid {
    static constexpr bool PERM = false, AFTER_DRAIN = false;
    const float* baseP; const float* baseS; float* out; int prow0, srow0;
    __device__ __forceinline__ void operator()(const f32x4 (&acc)[2][2][4][2], const Unit& u, int wr, int wc, int fr, int fq) const {
        asm volatile("" : "+v"(fr), "+v"(fq));
        const int lrow = u.pm * BM; const bool isP = lrow < 32768;
        const int grow = isP ? prow0 + lrow : srow0 + (lrow - 32768);
        const float* bp = isP ? baseP + (size_t)grow * 1024 : baseS + (size_t)(grow - 65536) * 1024;
        float* op = out + (size_t)grow * 1024;
        const int roff = wr * 64 + fr; const int col0 = u.pn * BM + wc * 32 + 4 * fq;
#pragma unroll
        for (int ai = 0; ai < 2; ++ai)
#pragma unroll
            for (int m = 0; m < 4; ++m) { const size_t off = (size_t)(roff + ai * HALF + m * 16) * 1024 + col0;
#pragma unroll
                for (int bj = 0; bj < 2; ++bj)
#pragma unroll
                    for (int n = 0; n < 2; ++n) { const f32x4 b = *(const f32x4*)(bp + off + bj * HALF + n * 16); *(f32x4*)(op + off + bj * HALF + n * 16) = b + acc[ai][bj][m][n]; }
                asm volatile("" ::: "memory"); }
    }
};

template <class Epi, class Sched, bool ALIGN_EPI = false, bool SP2 = false>
__device__ __forceinline__ void gemm_phase(PG8_LAS unsigned char* lds, const Gemm g, const Sched& S, const Epi& E, const int wave_s) {
    int tid = wave_s * 64 + (int)__builtin_amdgcn_mbcnt_hi(~0u, __builtin_amdgcn_mbcnt_lo(~0u, 0u)); asm volatile("" : "+v"(tid));
    const int wid = __builtin_amdgcn_readfirstlane(tid >> 6), lane = tid & 63, wr = wid >> 2, wc = wid & 3, fr = lane & 15, fq = lane >> 4;
    const int K = g.K, nt = K / BK;
    unsigned voffA[2], voffB[2];
#pragma unroll
    for (int i = 0; i < 2; ++i) { int R, C; stage_rc(tid * 16 + i * 8192, R, C); const int Rb = Epi::PERM ? ((R & ~31) + perm32(R & 31)) : R;
        voffA[i] = (unsigned)(R * g.lda + C) * 2u; voffB[i] = (unsigned)(Rb * g.ldb + C) * 2u; }
    const size_t kstep = (size_t)(BK * 2);
    const size_t hstepA = (size_t)HALF * g.lda * 2, hstepB = (size_t)HALF * g.ldb * 2;
    const size_t tstepA = 2 * hstepA, tstepB = 2 * hstepB;
    const unsigned ldsw = (unsigned)wid * 1024u;
    const int aoff = lds_byte(wr * 64 + fr, fq * 8), boff = lds_byte(wc * 32 + fr, fq * 8);
#define PG8_SA(b, h) (((b) * 2 + (h)) * HTB)
#define PG8_SB(b, h) ((4 + (b) * 2 + (h)) * HTB)
#define PG8_STAGE(bufoff, gbase, voff) do { _Pragma("unroll") for (int _i = 0; _i < 2; ++_i) \
        __builtin_amdgcn_global_load_lds((const unsigned*)((const char*)(gbase) + (voff)[_i]), (PG8_LAS unsigned*)(lds + (bufoff) + ldsw + _i * 8192), 16, 0, 0); } while (0)
#define PG8_LDA(dst, b, h) do { _Pragma("unroll") for (int m = 0; m < 4; ++m) _Pragma("unroll") for (int k = 0; k < 2; ++k) dst[m][k] = *(const PG8_LAS bf16x8*)(lds + PG8_SA(b, h) + aoff + m * 2048 + k * 1024); } while (0)
#define PG8_LDB(dst, b, h) do { _Pragma("unroll") for (int n = 0; n < 2; ++n) _Pragma("unroll") for (int k = 0; k < 2; ++k) dst[n][k] = *(const PG8_LAS bf16x8*)(lds + PG8_SB(b, h) + boff + n * 2048 + k * 1024); } while (0)
#define PG8_MMA(ai, bj, At, Bt) do { __builtin_amdgcn_s_setprio(1); _Pragma("unroll") for (int m = 0; m < 4; ++m) _Pragma("unroll") for (int n = 0; n < 2; ++n) _Pragma("unroll") for (int k = 0; k < 2; ++k) \
        acc[ai][bj][m][n] = __builtin_amdgcn_mfma_f32_16x16x32_bf16(Bt[n][k], At[m][k], acc[ai][bj][m][n], 0, 0, 0); __builtin_amdgcn_s_setprio(0); } while (0)
#define PG8_WAIT_V(n) asm volatile("s_waitcnt vmcnt(" #n ")" ::: "memory")
#define PG8_WAIT_L(n) asm volatile("s_waitcnt lgkmcnt(" #n ")" ::: "memory")
#define PG8_BAR __builtin_amdgcn_s_barrier()
#define PG8_SCHED __builtin_amdgcn_sched_barrier(0)
    Unit cur, nxt; int ui = 0;
    if (!S.next(0, cur)) return;
    f32x4 acc[2][2][4][2];
#pragma unroll
    for (int a = 0; a < 2; ++a)
#pragma unroll
        for (int b = 0; b < 2; ++b)
#pragma unroll
            for (int m = 0; m < 4; ++m)
#pragma unroll
                for (int n = 0; n < 2; ++n) acc[a][b][m][n] = (f32x4){0.f, 0.f, 0.f, 0.f};
    bf16x8 At[4][2], B0[2][2], B1[2][2];
    const char* cA = (const char*)g.A + (size_t)cur.pm * tstepA; const char* cB = (const char*)g.Bt + (size_t)cur.pn * tstepB;
    S.a_ready(cur);
    if constexpr (SP2) {
        PG8_STAGE(PG8_SB(0, 0), cB, voffB); PG8_STAGE(PG8_SB(0, 1), cB + hstepB, voffB); PG8_STAGE(PG8_SA(0, 0), cA, voffA); PG8_STAGE(PG8_SA(0, 1), cA + hstepA, voffA);
        if (wr == 1) PG8_BAR;
        PG8_WAIT_V(2); PG8_BAR;
        PG8_STAGE(PG8_SB(1, 0), cB + kstep, voffB); PG8_STAGE(PG8_SA(1, 0), cA + kstep, voffA); PG8_STAGE(PG8_SB(1, 1), cB + hstepB + kstep, voffB);
        PG8_WAIT_V(6); PG8_BAR;
    } else {
        PG8_STAGE(PG8_SB(0, 0), cB, voffB); PG8_STAGE(PG8_SA(0, 0), cA, voffA); PG8_STAGE(PG8_SB(0, 1), cB + hstepB, voffB); PG8_STAGE(PG8_SA(0, 1), cA + hstepA, voffA);
        if (wr == 1) PG8_BAR;
        PG8_WAIT_V(4); PG8_BAR;
        PG8_STAGE(PG8_SB(1, 0), cB + kstep, voffB); PG8_STAGE(PG8_SA(1, 0), cA + kstep, voffA); PG8_STAGE(PG8_SB(1, 1), cB + hstepB + kstep, voffB);
        PG8_WAIT_V(6); PG8_BAR;
    }
    for (;;) {
        const bool has_next = S.next(ui + 1, nxt);
        const char* nA = has_next ? (const char*)g.A + (size_t)nxt.pm * tstepA : cA; const char* nB = has_next ? (const char*)g.Bt + (size_t)nxt.pn * tstepB : cB;
        for (int t = 0; t < nt; t += 2) {
            const bool last = (t == nt - 2);
            const char* a1 = cA + (size_t)(t + 1) * kstep;
            const char* a2 = last ? nA : cA + (size_t)(t + 2) * kstep; const char* b2 = last ? nB : cB + (size_t)(t + 2) * kstep;
            const char* a3 = a2 + kstep; const char* b3 = b2 + kstep;
            if (last && has_next) S.a_ready(nxt);
            if constexpr (SP2) {
            PG8_LDB(B0, 0, 0); PG8_LDB(B1, 0, 1); PG8_SCHED; PG8_LDA(At, 0, 0); PG8_STAGE(PG8_SA(1, 1), a1 + hstepA, voffA);
            PG8_WAIT_V(8); PG8_WAIT_L(0); PG8_BAR; PG8_MMA(0, 0, At, B0); PG8_MMA(0, 1, At, B1); PG8_BAR; PG8_SCHED;
            PG8_LDA(At, 0, 1); PG8_STAGE(PG8_SB(0, 0), b2, voffB); PG8_STAGE(PG8_SB(0, 1), b2 + hstepB, voffB); PG8_STAGE(PG8_SA(0, 0), a2, voffA);
            PG8_WAIT_V(8); PG8_WAIT_L(0); PG8_BAR; PG8_MMA(1, 0, At, B0); PG8_MMA(1, 1, At, B1); PG8_BAR; PG8_SCHED;
            PG8_LDB(B0, 1, 0); PG8_LDB(B1, 1, 1); PG8_SCHED; PG8_LDA(At, 1, 0); PG8_STAGE(PG8_SA(0, 1), a2 + hstepA, voffA);
            PG8_WAIT_V(8); PG8_WAIT_L(0); PG8_BAR; PG8_MMA(0, 0, At, B0); PG8_MMA(0, 1, At, B1); PG8_BAR; PG8_SCHED;
            PG8_LDA(At, 1, 1); PG8_STAGE(PG8_SB(1, 0), b3, voffB); PG8_STAGE(PG8_SB(1, 1), b3 + hstepB, voffB); PG8_STAGE(PG8_SA(1, 0), a3, voffA);
            PG8_WAIT_V(8); PG8_WAIT_L(0); PG8_BAR; PG8_MMA(1, 0, At, B0); PG8_MMA(1, 1, At, B1); PG8_BAR; PG8_SCHED;
            } else {
            PG8_LDB(B0, 0, 0); PG8_SCHED; PG8_LDA(At, 0, 0); PG8_STAGE(PG8_SA(1, 1), a1 + hstepA, voffA);
            PG8_WAIT_L(8); PG8_BAR; PG8_WAIT_L(0); PG8_MMA(0, 0, At, B0); PG8_BAR; PG8_SCHED;
            PG8_LDB(B1, 0, 1); PG8_STAGE(PG8_SB(0, 0), b2, voffB);
            PG8_BAR; PG8_WAIT_L(0); PG8_MMA(0, 1, At, B1); PG8_BAR;
            PG8_LDA(At, 0, 1); PG8_STAGE(PG8_SA(0, 0), a2, voffA);
            PG8_BAR; PG8_WAIT_L(0); PG8_MMA(1, 0, At, B0); PG8_BAR; PG8_SCHED;
            PG8_STAGE(PG8_SB(0, 1), b2 + hstepB, voffB);
            PG8_WAIT_V(6); PG8_BAR; PG8_MMA(1, 1, At, B1); PG8_BAR;
            PG8_LDB(B0, 1, 0); PG8_SCHED; PG8_LDA(At, 1, 0); PG8_STAGE(PG8_SA(0, 1), a2 + hstepA, voffA);
            PG8_WAIT_L(8); PG8_BAR; PG8_WAIT_L(0); PG8_MMA(0, 0, At, B0); PG8_BAR; PG8_SCHED;
            PG8_LDB(B1, 1, 1); PG8_STAGE(PG8_SB(1, 0), b3, voffB);
            PG8_BAR; PG8_WAIT_L(0); PG8_MMA(0, 1, At, B1); PG8_BAR;
            PG8_LDA(At, 1, 1); PG8_STAGE(PG8_SA(1, 0), a3, voffA);
            PG8_BAR; PG8_WAIT_L(0); PG8_MMA(1, 0, At, B0); PG8_BAR; PG8_SCHED;
            PG8_STAGE(PG8_SB(1, 1), b3 + hstepB, voffB);
            PG8_WAIT_V(6); PG8_BAR; PG8_MMA(1, 1, At, B1); PG8_BAR;
            }
        }
        if constexpr (ALIGN_EPI) { if (wr == 0) PG8_BAR; }
        if constexpr (!Epi::AFTER_DRAIN) { E(acc, cur, wr, wc, fr, fq); S.done(cur); }
        if (!has_next) break;
#pragma unroll
        for (int a = 0; a < 2; ++a)
#pragma unroll
            for (int b = 0; b < 2; ++b)
#pragma unroll
                for (int m = 0; m < 4; ++m)
#pragma unroll
                    for (int n = 0; n < 2; ++n) acc[a][b][m][n] = (f32x4){0.f, 0.f, 0.f, 0.f};
        cur = nxt; cA = nA; cB = nB; ++ui;
        if constexpr (ALIGN_EPI) { if (wr == 1) PG8_BAR; }
    }
    PG8_WAIT_V(0);
    if constexpr (!ALIGN_EPI) { if (wr == 0) PG8_BAR; }
    PG8_BAR;
    if constexpr (Epi::AFTER_DRAIN) { E.fused(acc, cur, wr, wc, fr, fq, lds, wid, lane); S.done(cur); }
#undef PG8_SA
#undef PG8_SB
#undef PG8_STAGE
#undef PG8_LDA
#undef PG8_LDB
#undef PG8_MMA
#undef PG8_WAIT_V
#undef PG8_WAIT_L
#undef PG8_BAR
#undef PG8_SCHED
}

template <class Epi, class Sched>
__device__ __forceinline__ void gemm_phase2(PG8_LAS unsigned char* lds, const Gemm g, const Sched& S, const Epi& E, const int wave_s) {
    int tid = wave_s * 64 + (int)__builtin_amdgcn_mbcnt_hi(~0u, __builtin_amdgcn_mbcnt_lo(~0u, 0u)); asm volatile("" : "+v"(tid));
    const int wid = __builtin_amdgcn_readfirstlane(tid >> 6), lane = tid & 63, wr = wid >> 2, wc = wid & 3, fr = lane & 15, fq = lane >> 4;
    const int K = g.K, nt = K / BK;
    unsigned voffA[2], voffB[2];
#pragma unroll
    for (int i = 0; i < 2; ++i) { int R, C; stage_rc(tid * 16 + i * 8192, R, C); const int Rb = Epi::PERM ? ((R & ~31) + perm32(R & 31)) : R;
        voffA[i] = (unsigned)(R * g.lda + C) * 2u; voffB[i] = (unsigned)(Rb * g.ldb + C) * 2u; }
    const size_t kstep = (size_t)(BK * 2);
    const size_t hstepA = (size_t)HALF * g.lda * 2, hstepB = (size_t)HALF * g.ldb * 2;
    const size_t tstepA = 2 * hstepA, tstepB = 2 * hstepB;
    const unsigned ldst = (unsigned)tid * 16u;
    const int aoff = lds_byte(wr * 64 + fr, fq * 8), boff = lds_byte(wc * 32 + fr, fq * 8);
#define PG8_SA(b, h) (((b) * 2 + (h)) * HTB)
#define PG8_SB(b, h) ((4 + (b) * 2 + (h)) * HTB)
#define PG8_LDA(dst, b, h) do { _Pragma("unroll") for (int m = 0; m < 4; ++m) _Pragma("unroll") for (int k = 0; k < 2; ++k) dst[m][k] = *(const PG8_LAS bf16x8*)(lds + PG8_SA(b, h) + aoff + m * 2048 + k * 1024); } while (0)
#define PG8_LDB(dst, b, h) do { _Pragma("unroll") for (int n = 0; n < 2; ++n) _Pragma("unroll") for (int k = 0; k < 2; ++k) dst[n][k] = *(const PG8_LAS bf16x8*)(lds + PG8_SB(b, h) + boff + n * 2048 + k * 1024); } while (0)
#define PG8_MMA(ai, bj, At, Bt) do { _Pragma("unroll") for (int m = 0; m < 4; ++m) _Pragma("unroll") for (int n = 0; n < 2; ++n) _Pragma("unroll") for (int k = 0; k < 2; ++k) \
        acc[ai][bj][m][n] = __builtin_amdgcn_mfma_f32_16x16x32_bf16(Bt[n][k], At[m][k], acc[ai][bj][m][n], 0, 0, 0); } while (0)
    Unit cur;
    for (int ui = 0; S.next(ui, cur); ++ui) {
        f32x4 acc[2][2][4][2];
#pragma unroll
        for (int a = 0; a < 2; ++a)
#pragma unroll
            for (int b = 0; b < 2; ++b)
#pragma unroll
                for (int m = 0; m < 4; ++m)
#pragma unroll
                    for (int n = 0; n < 2; ++n) acc[a][b][m][n] = (f32x4){0.f, 0.f, 0.f, 0.f};
        const char* cA = (const char*)g.A + (size_t)cur.pm * tstepA; const char* cB = (const char*)g.Bt + (size_t)cur.pn * tstepB;
        u32x4 ra[2][2], rb[2][2];
#pragma unroll
        for (int h = 0; h < 2; ++h)
#pragma unroll
            for (int i = 0; i < 2; ++i) { ra[h][i] = *(const u32x4*)(cA + h * hstepA + voffA[i]); rb[h][i] = *(const u32x4*)(cB + h * hstepB + voffB[i]); }
        for (int t = 0; t < nt; ++t) {
            const int b = t & 1;
#pragma unroll
            for (int h = 0; h < 2; ++h)
#pragma unroll
                for (int i = 0; i < 2; ++i) { *(PG8_LAS u32x4*)(lds + PG8_SA(b, h) + ldst + i * 8192) = ra[h][i]; *(PG8_LAS u32x4*)(lds + PG8_SB(b, h) + ldst + i * 8192) = rb[h][i]; }
            __syncthreads();
            if (t + 1 < nt) {
                const char* nA = cA + (size_t)(t + 1) * kstep; const char* nB = cB + (size_t)(t + 1) * kstep;
#pragma unroll
                for (int h = 0; h < 2; ++h)
#pragma unroll
                    for (int i = 0; i < 2; ++i) { ra[h][i] = *(const u32x4*)(nA + h * hstepA + voffA[i]); rb[h][i] = *(const u32x4*)(nB + h * hstepB + voffB[i]); }
            }
            bf16x8 At[4][2], B0[2][2];
            PG8_LDB(B0, b, 0); PG8_LDA(At, b, 0); PG8_MMA(0, 0, At, B0); __builtin_amdgcn_sched_barrier(0);
            PG8_LDA(At, b, 1); PG8_MMA(1, 0, At, B0); __builtin_amdgcn_sched_barrier(0);
            PG8_LDB(B0, b, 1); PG8_MMA(1, 1, At, B0); __builtin_amdgcn_sched_barrier(0);
            PG8_LDA(At, b, 0); PG8_MMA(0, 1, At, B0); __builtin_amdgcn_sched_barrier(0);
        }
        E(acc, cur, wr, wc, fr, fq);
    }
    __syncthreads();
#undef PG8_SA
#undef PG8_SB
#undef PG8_LDA
#undef PG8_LDB
#undef PG8_MMA
}
}


#define LAS __attribute__((address_space(3)))
#define GAS __attribute__((address_space(1)))
typedef unsigned short bf16;
typedef short bf16x8 __attribute__((ext_vector_type(8)));
typedef float f32x4 __attribute__((ext_vector_type(4)));
typedef float f32x16 __attribute__((ext_vector_type(16)));
typedef unsigned u32x4 __attribute__((ext_vector_type(4)));
typedef unsigned u32x2 __attribute__((ext_vector_type(2)));
typedef float f32x2 __attribute__((ext_vector_type(2)));

constexpr int DM = 1024, DFF = 4096, INC = 4352, ZLD = 2304, GLD = 2048;
constexpr int NP = 8192, NS = 4096;
constexpr int MC = 49152;
constexpr int MC_P = 32768;
constexpr int MTOT = 98304, MPROMPT = 65536;
constexpr float C2 = 0.125f * 1.4426950408889634f;
constexpr float LOG2E = 1.4426950408889634f;
constexpr int NWAVES = 8, NTHR = 512;

constexpr size_t MiB = 1u << 20;
constexpr size_t WS_CTL = 0;
constexpr size_t WS_WIN = 1 * MiB;
constexpr size_t WS_WUA = WS_WIN + (size_t)2 * INC * DM * 2;
constexpr size_t WS_WUB = WS_WUA + (size_t)2 * DM * 512 * 2;
constexpr size_t WS_WO  = WS_WUB + (size_t)2 * DM * 512 * 2;
constexpr size_t WS_W1  = WS_WO + (size_t)2 * DM * DM * 2;
constexpr size_t WS_W2  = WS_W1 + (size_t)2 * DFF * DM * 2;
constexpr size_t WS_WEND = WS_W2 + (size_t)2 * DFF * DM * 2;
static_assert(WS_WEND <= 64 * MiB, "weights");
constexpr size_t WS_H = 64 * MiB;
constexpr size_t WS_OAB = 160 * MiB;
constexpr size_t WS_U = 256 * MiB;
constexpr size_t WS_Z = 352 * MiB;
constexpr size_t WS_G = 568 * MiB;
constexpr size_t WS_VTA = 760 * MiB;
constexpr size_t WS_VTB = 808 * MiB;
constexpr size_t WS_END = 820 * MiB;
constexpr size_t WS_ACT = 352 * MiB;
static_assert(WS_ACT + (size_t)MC * DFF * 2 <= WS_VTA, "act overlay");

constexpr int RING_BYTES = 131072;
constexpr int MISC_OFF = RING_BYTES;
constexpr int BT_N = 513;
constexpr int PTAB_OFF = MISC_OFF + 8320;
constexpr int WSF_OFF = MISC_OFF + 8576;
constexpr int LDS_BYTES = RING_BYTES + 8576 + 1024;
static_assert(64 + 4 * BT_N * 4 <= 8320, "lds");

struct Params {
    const float* in[20];
    float* out; unsigned char* ws;
};

__device__ __forceinline__ unsigned cvtpk(float lo, float hi) { return pg8::cvt_pk_bf16(lo, hi); }
__device__ __forceinline__ float bflo(unsigned w) { return __uint_as_float(w << 16); }
__device__ __forceinline__ float bfhi(unsigned w) { return __uint_as_float(w & 0xffff0000u); }
__device__ __forceinline__ float bf2f(bf16 v) { return __uint_as_float((unsigned)v << 16); }
__device__ __forceinline__ bf16 f2bf(float f) { return (bf16)(cvtpk(f, 0.f) & 0xffffu); }
__device__ __forceinline__ float bperm(float v, int byteaddr) { return __int_as_float(__builtin_amdgcn_ds_bpermute(byteaddr, __float_as_int(v))); }
__device__ __forceinline__ float wave_sum(float v, int lane) {
#pragma unroll
    for (int o = 1; o < 64; o <<= 1) v += bperm(v, (lane ^ o) << 2);
    return v;
}
__device__ __forceinline__ float half_sum(float v, int lane) {
#pragma unroll
    for (int o = 1; o < 32; o <<= 1) v += bperm(v, (lane ^ o) << 2);
    return v;
}
__device__ __forceinline__ float xmax32(float v) { auto rr = __builtin_amdgcn_permlane32_swap(__float_as_uint(v), __float_as_uint(v), false, false); return fmaxf(__uint_as_float(rr[0]), __uint_as_float(rr[1])); }
__device__ __forceinline__ float xsum32(float v) { auto rr = __builtin_amdgcn_permlane32_swap(__float_as_uint(v), __float_as_uint(v), false, false); return __uint_as_float(rr[0]) + __uint_as_float(rr[1]); }
__device__ __forceinline__ int my_tid(int wave) { int t = wave * 64 + (int)__builtin_amdgcn_mbcnt_hi(~0u, __builtin_amdgcn_mbcnt_lo(~0u, 0u)); asm volatile("" : "+v"(t)); return t; }
__device__ __forceinline__ int crow(int r, int hi) { return (r & 3) + 8 * (r >> 2) + 4 * hi; }

__device__ __forceinline__ void p0_transpose_item(const float* W, int K, int N, bf16* WT, LAS float* scr, int item, int lane) {
    const int nblk = N / 32, kb = item / nblk, nb = item % nblk, k0 = 64 * kb, n0 = 32 * nb;
    const GAS float* Wg = (const GAS float*)W + (size_t)(k0 + (lane >> 5)) * N + n0 + (lane & 31);
#pragma unroll
    for (int h = 0; h < 2; ++h) {
        float wv[16];
#pragma unroll
        for (int i = 0; i < 16; ++i) wv[i] = Wg[(size_t)(2 * (16 * h + i)) * N];
#pragma unroll
        for (int i = 0; i < 16; ++i) { const int kk = 2 * (16 * h + i) + (lane >> 5); scr[kk * 33 + (lane & 31)] = wv[i]; }
    }
    asm volatile("s_waitcnt lgkmcnt(0)" ::: "memory");
    const int c = lane & 7;
#pragma unroll
    for (int j = 0; j < 4; ++j) { const int n = (lane >> 3) + 8 * j; const LAS float* s = scr + (8 * c) * 33 + n;
        u32x4 o; o.x = cvtpk(s[0 * 33], s[1 * 33]); o.y = cvtpk(s[2 * 33], s[3 * 33]); o.z = cvtpk(s[4 * 33], s[5 * 33]); o.w = cvtpk(s[6 * 33], s[7 * 33]);
        *(GAS u32x4*)(WT + (size_t)(n0 + n) * K + k0 + 8 * c) = o; }
    asm volatile("s_waitcnt lgkmcnt(0)" ::: "memory");
}

__device__ __forceinline__ void rms_row_to_bf16(const float* xrow, const float* g, bf16* orow, int lane) {
    const GAS f32x4* xr = (const GAS f32x4*)xrow + lane; const GAS f32x4* gr = (const GAS f32x4*)g + lane;
    f32x4 v[4]; float s = 0.f;
#pragma unroll
    for (int j = 0; j < 4; ++j) { v[j] = __builtin_nontemporal_load(&xr[64 * j]); s += (v[j].x * v[j].x + v[j].y * v[j].y) + (v[j].z * v[j].z + v[j].w * v[j].w); }
    const float rstd = 1.f / sqrtf(wave_sum(s, lane) * (1.f / DM) + 1e-6f);
    GAS u32x2* o8 = (GAS u32x2*)orow + lane;
#pragma unroll
    for (int j = 0; j < 4; ++j) { const f32x4 gg = gr[64 * j]; u32x2 w; w.x = cvtpk(v[j].x * rstd * gg.x, v[j].y * rstd * gg.y); w.y = cvtpk(v[j].z * rstd * gg.z, v[j].w * rstd * gg.w); o8[64 * j] = w; }
}
__device__ __forceinline__ void rms_row2_to_bf16(const float* xrow0, const float* xrow1, const float* g, bf16* orow0, bf16* orow1, int lane) {
    const GAS f32x4* x0 = (const GAS f32x4*)xrow0 + lane; const GAS f32x4* x1 = (const GAS f32x4*)xrow1 + lane; const GAS f32x4* gr = (const GAS f32x4*)g + lane;
    f32x4 v0[4], v1[4]; float s0 = 0.f, s1 = 0.f;
#pragma unroll
    for (int j = 0; j < 4; ++j) { v0[j] = __builtin_nontemporal_load(&x0[64 * j]); v1[j] = __builtin_nontemporal_load(&x1[64 * j]); }
#pragma unroll
    for (int j = 0; j < 4; ++j) { s0 += (v0[j].x * v0[j].x + v0[j].y * v0[j].y) + (v0[j].z * v0[j].z + v0[j].w * v0[j].w); s1 += (v1[j].x * v1[j].x + v1[j].y * v1[j].y) + (v1[j].z * v1[j].z + v1[j].w * v1[j].w); }
#pragma unroll
    for (int o = 1; o < 64; o <<= 1) { s0 += bperm(s0, (lane ^ o) << 2); s1 += bperm(s1, (lane ^ o) << 2); }
    const float r0 = 1.f / sqrtf(s0 * (1.f / DM) + 1e-6f), r1 = 1.f / sqrtf(s1 * (1.f / DM) + 1e-6f);
    GAS u32x2* o0 = (GAS u32x2*)orow0 + lane; GAS u32x2* o1 = (GAS u32x2*)orow1 + lane;
#pragma unroll
    for (int j = 0; j < 4; ++j) { const f32x4 gg = gr[64 * j];
        u32x2 w; w.x = cvtpk(v0[j].x * r0 * gg.x, v0[j].y * r0 * gg.y); w.y = cvtpk(v0[j].z * r0 * gg.z, v0[j].w * r0 * gg.w); o0[64 * j] = w;
        u32x2 u; u.x = cvtpk(v1[j].x * r1 * gg.x, v1[j].y * r1 * gg.y); u.y = cvtpk(v1[j].z * r1 * gg.z, v1[j].w * r1 * gg.w); o1[64 * j] = u; }
}
__device__ __forceinline__ void rms_row_f32_inplace(float* xrow, const float* g, int lane) {
    GAS f32x4* xr = (GAS f32x4*)xrow + lane; const GAS f32x4* gr = (const GAS f32x4*)g + lane;
    f32x4 v[4]; float s = 0.f;
#pragma unroll
    for (int j = 0; j < 4; ++j) { v[j] = __builtin_nontemporal_load(&xr[64 * j]); s += (v[j].x * v[j].x + v[j].y * v[j].y) + (v[j].z * v[j].z + v[j].w * v[j].w); }
    const float rstd = 1.f / sqrtf(wave_sum(s, lane) * (1.f / DM) + 1e-6f);
#pragma unroll
    for (int j = 0; j < 4; ++j) { const f32x4 gg = gr[64 * j]; __builtin_nontemporal_store(v[j] * rstd * gg, &xr[64 * j]); }
}

__device__ __forceinline__ void prepass_tile(bf16* Z, bf16* VtA, bf16* VtB, const float* gq, const float* gk, int m0, int tok0, int N, LAS unsigned char* lds, int wave, int lane) {
    asm volatile("" : "+v"(lane));
    for (int pass = 0; pass < 2; ++pass) {
        const int it = wave * 80 + pass * 64 + lane;
        if (pass == 1 && lane >= 16) break;
        const int tk = it / 10, hd = it - tk * 10;
        const int mrow = m0 + tk, n = mrow - tok0;
        const bool isq = hd < 8;
        GAS u32x4* hp = (GAS u32x4*)(Z + (size_t)mrow * ZLD + (isq ? 1536 + hd * 64 : 2048 + (hd - 8) * 64));
        u32x4 w[8];
#pragma unroll
        for (int k = 0; k < 8; ++k) w[k] = hp[k];
        float x[64]; float ss = 0.f;
#pragma unroll
        for (int k = 0; k < 8; ++k) { x[8 * k + 0] = bflo(w[k].x); x[8 * k + 1] = bfhi(w[k].x); x[8 * k + 2] = bflo(w[k].y); x[8 * k + 3] = bfhi(w[k].y);
                                      x[8 * k + 4] = bflo(w[k].z); x[8 * k + 5] = bfhi(w[k].z); x[8 * k + 6] = bflo(w[k].w); x[8 * k + 7] = bfhi(w[k].w); }
#pragma unroll
        for (int d = 0; d < 64; ++d) ss += x[d] * x[d];
        const float rstd = 1.f / sqrtf(ss * (1.f / 64.f) + 1e-6f);
        const float* gg = isq ? gq : gk;
        const float osc = isq ? C2 : 1.f;
        const float prow = (float)(n >> 6), pcol = (float)(n & 63);
#pragma unroll
        for (int j = 0; j < 16; ++j) {
            constexpr float INVT[16] = {1.591549431e-01f, 8.949940161e-02f, 5.032921210e-02f, 2.830219583e-02f, 1.591549431e-02f, 8.949940161e-03f, 5.032921210e-03f, 2.830219583e-03f, 1.591549431e-03f, 8.949940161e-04f, 5.032921210e-04f, 2.830219583e-04f, 1.591549431e-04f, 8.949940161e-05f, 5.032921210e-05f, 2.830219583e-05f};
            const float inv = INVT[j];
            { const float rev = prow * inv, cs = __builtin_amdgcn_cosf(rev), sn = __builtin_amdgcn_sinf(rev);
              const float y1 = x[j] * rstd * gg[j], y2 = x[j + 16] * rstd * gg[j + 16];
              x[j] = (y1 * cs - y2 * sn) * osc; x[j + 16] = (y2 * cs + y1 * sn) * osc; }
            { const float rev = pcol * inv, cs = __builtin_amdgcn_cosf(rev), sn = __builtin_amdgcn_sinf(rev);
              const float y1 = x[32 + j] * rstd * gg[32 + j], y2 = x[48 + j] * rstd * gg[48 + j];
              x[32 + j] = (y1 * cs - y2 * sn) * osc; x[48 + j] = (y2 * cs + y1 * sn) * osc; }
        }
#pragma unroll
        for (int k = 0; k < 8; ++k) { u32x4 o4; o4.x = cvtpk(x[8 * k + 0], x[8 * k + 1]); o4.y = cvtpk(x[8 * k + 2], x[8 * k + 3]); o4.z = cvtpk(x[8 * k + 4], x[8 * k + 5]); o4.w = cvtpk(x[8 * k + 6], x[8 * k + 7]); hp[k] = o4; }
    }
    LAS bf16* scr = (LAS bf16*)(lds + wave * 9216);
    const int n0 = m0 - tok0;
    for (int item = wave; item < 10; item += 8) {
        const int scol = item < 8 ? 1024 + 64 * item : 2176 + 64 * (item - 8);
        bf16* dst = item < 8 ? VtA + (size_t)tok0 * 512 + (size_t)(64 * item) * N : VtB + (size_t)tok0 * 128 + (size_t)(64 * (item - 8)) * N;
        u32x4 v[8];
#pragma unroll
        for (int it = 0; it < 8; ++it) { const int row = 8 * it + (lane >> 3), ch = lane & 7; v[it] = *(const GAS u32x4*)(Z + (size_t)(m0 + row) * ZLD + scol + ch * 8); }
#pragma unroll
        for (int it = 0; it < 8; ++it) { const int row = 8 * it + (lane >> 3), ch = lane & 7; *(LAS u32x4*)(scr + row * 72 + ch * 8) = v[it]; }
        asm volatile("s_waitcnt lgkmcnt(0)" ::: "memory");
#pragma unroll
        for (int it = 0; it < 8; ++it) { const int d = 8 * it + (lane >> 3), ch = lane & 7;
            unsigned short e[8];
#pragma unroll
            for (int k = 0; k < 8; ++k) e[k] = scr[(8 * ch + k) * 72 + d];
            u32x4 w; w.x = e[0] | ((unsigned)e[1] << 16); w.y = e[2] | ((unsigned)e[3] << 16); w.z = e[4] | ((unsigned)e[5] << 16); w.w = e[6] | ((unsigned)e[7] << 16);
            *(GAS u32x4*)(dst + (size_t)d * N + n0 + ch * 8) = w; }
        asm volatile("s_waitcnt lgkmcnt(0)" ::: "memory");
    }
}

template <int KW, int DV, bool BIAS>
__device__ __forceinline__ void attn_core(LAS unsigned char* lds, const bf16* __restrict__ Qw, const bf16* __restrict__ Kg, const bf16* __restrict__ Vtg,
                                          int N, int kc, int qpos0, const LAS float* btab, f32x16 (&o)[DV / 32], const int wave_s) {
    const int tid = my_tid(wave_s);
    const int lane = tid & 63, r32 = lane & 31, hi = lane >> 5;
    constexpr int KPR = KW / 8, KP = 64 * KPR / NTHR, VP = DV * 8 / NTHR;
    constexpr int KBYTES = 64 * KW * 2, VBYTES = DV * 128, BUF = KBYTES + VBYTES;
    constexpr float THR = 8.f;
    const int NT = N / 64;
    const int krow = tid / KPR, kch = tid % KPR, vrow = tid >> 3, vch = tid & 7;
    const int sxk_w = (KW == 128) ? (krow & 15) : ((krow >> 1) & 7);
    LAS unsigned char* const kdst = lds + krow * (KW * 2) + ((kch ^ sxk_w) * 16);
    const int vsx = (vrow >> 1) & 7;
    LAS unsigned char* const vdst0 = lds + KBYTES + vrow * 128 + (((vch & ~1) ^ vsx) * 16) + (vch & 1) * 8;
    LAS unsigned char* const vdst1 = lds + KBYTES + vrow * 128 + (((vch | 1) ^ vsx) * 16) + (vch & 1) * 8;
    constexpr int KDSTEP = (NTHR / KPR) * KW * 2, VDSTEP = 64 * 128;
    const bf16* ksrc = Kg + (size_t)krow * ZLD + kch * 8;
    const bf16* vsrc = Vtg + (size_t)vrow * (size_t)N + vch * 8;
    u32x4 kreg[KP], vreg[VP];
#pragma unroll
    for (int i = 0; i < KP; ++i) kreg[i] = *(const GAS u32x4*)(ksrc + (size_t)((NTHR / KPR) * i) * ZLD);
#pragma unroll
    for (int i = 0; i < VP; ++i) vreg[i] = *(const GAS u32x4*)(vsrc + (size_t)(64 * i) * (size_t)N);
    bf16x8 qr[4];
#pragma unroll
    for (int d0 = 0; d0 < 4; ++d0) qr[d0] = *(const GAS bf16x8*)(Qw + (size_t)r32 * ZLD + d0 * 16 + hi * 8);
    LAS float* wsf = (LAS float*)(lds + WSF_OFF) + (tid >> 6) * 32;
    const LAS unsigned char* kaddr[4]; const LAS unsigned char* vaddr[4];
#pragma unroll
    for (int d0 = 0; d0 < 4; ++d0) kaddr[d0] = lds + r32 * (KW * 2) + (((kc / 8 + 2 * d0 + hi) ^ ((KW == 128) ? (r32 & 15) : ((r32 >> 1) & 7))) * 16);
#pragma unroll
    for (int j = 0; j < 4; ++j) vaddr[j] = lds + KBYTES + r32 * 128 + (((2 * j + hi) ^ ((r32 >> 1) & 7)) * 16);
    float cbl = 0.f, cbr = 0.f;
    if (BIAS) { cbl = btab[0]; cbr = btab[512]; }
    const LAS float* btq = btab + (256 + 4 * hi - (qpos0 + r32));
    float mhat = 0.f, l = 0.f;
    constexpr bool NEGM = (!BIAS && DV == 64);
    f32x16 negm = f32x16{};
    float cb = 0.f;
#pragma unroll
    for (int d = 0; d < DV / 32; ++d) o[d] = f32x16{};

#define LDK(PAR, KB) do { _Pragma("unroll") for (int d0 = 0; d0 < 4; ++d0) kf[d0] = *(const LAS bf16x8*)(kaddr[d0] + ((PAR) * BUF + (KB) * 32 * KW * 2)); } while (0)
#define LDV(DST, PAR, DP, KB) do { _Pragma("unroll") for (int dd = 0; dd < 2; ++dd) _Pragma("unroll") for (int jj = 0; jj < 2; ++jj) \
            DST[dd][jj] = *(const LAS u32x4*)(vaddr[2 * (KB) + jj] + ((PAR) * BUF + ((DP) * 2 + dd) * 32 * 128)); } while (0)
#define QKCHAIN() do { if (NEGM) { __builtin_amdgcn_s_setprio(1); p = __builtin_amdgcn_mfma_f32_32x32x16_bf16(kf[0], qr[0], negm, 0, 0, 0); _Pragma("unroll") for (int d0 = 1; d0 < 4; ++d0) p = __builtin_amdgcn_mfma_f32_32x32x16_bf16(kf[d0], qr[d0], p, 0, 0, 0); __builtin_amdgcn_s_setprio(0); } \
        else { const float ci_ = cb - mhat; _Pragma("unroll") for (int r = 0; r < 16; ++r) p[r] = ci_; __builtin_amdgcn_s_setprio(1); _Pragma("unroll") for (int d0 = 0; d0 < 4; ++d0) p = __builtin_amdgcn_mfma_f32_32x32x16_bf16(kf[d0], qr[d0], p, 0, 0, 0); __builtin_amdgcn_s_setprio(0); } } while (0)
#define PVGROUP(VF, DP) do { __builtin_amdgcn_s_setprio(1); _Pragma("unroll") for (int dd = 0; dd < 2; ++dd) _Pragma("unroll") for (int jj = 0; jj < 2; ++jj) \
            o[2 * (DP) + dd] = __builtin_amdgcn_mfma_f32_32x32x16_bf16(__builtin_bit_cast(bf16x8, pw[jj]), __builtin_bit_cast(bf16x8, VF[dd][jj]), o[2 * (DP) + dd], 0, 0, 0); __builtin_amdgcn_s_setprio(0); } while (0)
#define TILE(PAR, t) do { \
        _Pragma("unroll") for (int i = 0; i < KP; ++i) *(LAS u32x4*)(kdst + ((PAR) * BUF + i * KDSTEP)) = kreg[i]; \
        _Pragma("unroll") for (int i = 0; i < VP; ++i) { *(LAS u32x2*)(vdst0 + ((PAR) * BUF + i * VDSTEP)) = (u32x2){vreg[i].x, vreg[i].y}; *(LAS u32x2*)(vdst1 + ((PAR) * BUF + i * VDSTEP)) = (u32x2){vreg[i].z, vreg[i].w}; } \
        __syncthreads(); \
        if ((t) + 1 < NT) { const bf16* kn = ksrc + (size_t)((t) + 1) * 64 * ZLD; const bf16* vn_ = vsrc + ((t) + 1) * 64; \
            _Pragma("unroll") for (int i = 0; i < KP; ++i) kreg[i] = *(const GAS u32x4*)(kn + (size_t)((NTHR / KPR) * i) * ZLD); \
            _Pragma("unroll") for (int i = 0; i < VP; ++i) vreg[i] = *(const GAS u32x4*)(vn_ + (size_t)(64 * i) * (size_t)N); } \
        const int k0 = (t) * 64; bool near = false; \
        if (BIAS) { const int relmax = k0 + 63 - qpos0, relmin = k0 - (qpos0 + 31); const int st_ = relmax <= -128 ? 0 : (relmin >= 128 ? 2 : 1); near = st_ == 1; \
            cb = st_ == 0 ? cbl : (st_ == 2 ? cbr : 0.f); } \
        bf16x8 kf[4]; u32x4 vfa[2][2]; f32x16 p; \
        LDK(PAR, 0); QKCHAIN(); \
        __builtin_amdgcn_sched_barrier(0); \
        _Pragma("unroll") for (int kb = 0; kb < 2; ++kb) { \
            if (kb == 0) LDK(PAR, 1); \
            LDV(vfa, PAR, 0, kb); \
            __builtin_amdgcn_sched_barrier(0); \
            if (BIAS && near) { const LAS float* bt = btq + (k0 + 32 * kb); _Pragma("unroll") for (int r = 0; r < 16; ++r) p[r] += bt[(r & 3) + 8 * (r >> 2)]; } \
            float rm = fmaxf(p[0], p[1]); \
            _Pragma("unroll") for (int r = 2; r < 16; ++r) rm = fmaxf(rm, p[r]); \
            rm = xmax32(rm); \
            const bool first = ((t) == 0) && (kb == 0); \
            if (first || __any(rm > THR)) { \
                const float dl = first ? rm : fmaxf(rm, 0.f); \
                mhat += dl; \
                _Pragma("unroll") for (int r = 0; r < 16; ++r) p[r] -= dl; \
                if (NEGM) { const float nm_ = -mhat; _Pragma("unroll") for (int r = 0; r < 16; ++r) negm[r] = nm_; } \
                if (!first) { \
                    const float f = __builtin_amdgcn_exp2f(-dl); l *= f; \
                    wsf[r32] = f; \
                    _Pragma("unroll") for (int r = 0; r < 16; ++r) { const float fr = wsf[crow(r, hi)]; \
                        _Pragma("unroll") for (int d = 0; d < DV / 32; ++d) o[d][r] *= fr; } \
                } \
            } \
            _Pragma("unroll") for (int r = 0; r < 16; ++r) p[r] = __builtin_amdgcn_exp2f(p[r]); \
            { f32x2 s2 = (f32x2){p[0], p[1]}; _Pragma("unroll") for (int r = 2; r < 16; r += 2) s2 += (f32x2){p[r], p[r + 1]}; l += s2.x + s2.y; } \
            u32x4 pw[2]; \
            _Pragma("unroll") for (int e = 0; e < 4; ++e) { pw[0][e] = cvtpk(p[2 * e], p[2 * e + 1]); pw[1][e] = cvtpk(p[8 + 2 * e], p[8 + 2 * e + 1]); } \
            __builtin_amdgcn_sched_barrier(0); \
            if (kb == 0) QKCHAIN(); \
            PVGROUP(vfa, 0); \
            if (DV == 128) { LDV(vfa, PAR, 1, kb); PVGROUP(vfa, 1); } \
            __builtin_amdgcn_sched_barrier(0); \
        } \
    } while (0)

    for (int t = 0; t < NT; t += 2) { TILE(0, t); TILE(1, t + 1); }
#undef TILE
#undef PVGROUP
#undef QKCHAIN
#undef LDK
#undef LDV
    l = xsum32(l);
    wsf[r32] = 1.f / l;
#pragma unroll
    for (int r = 0; r < 16; ++r) { const float fr = wsf[crow(r, hi)];
#pragma unroll
        for (int d = 0; d < DV / 32; ++d) o[d][r] *= fr; }
}


__device__ __forceinline__ void attn_core_gqa2(LAS unsigned char* lds, const bf16* __restrict__ Qw, const bf16* __restrict__ Kg, const bf16* __restrict__ Vtg,
                                               int N, f32x16 (&o)[2][2], const int wave_s) {
    const int tid = my_tid(wave_s);
    const int lane = tid & 63, r32 = lane & 31, hi = lane >> 5;
    constexpr int KW = 64, KBYTES = 64 * KW * 2, BUF = KBYTES + 64 * 128;
    constexpr float THR = 8.f;
    const int NT = N / 64;
    const int krow = tid >> 3, kch = tid & 7, vrow = tid >> 3, vch = tid & 7;
    LAS unsigned char* const kdst = lds + krow * 128 + ((kch ^ ((krow >> 1) & 7)) * 16);
    const int vsx = (vrow >> 1) & 7;
    LAS unsigned char* const vdst0 = lds + KBYTES + vrow * 128 + (((vch & ~1) ^ vsx) * 16) + (vch & 1) * 8;
    LAS unsigned char* const vdst1 = lds + KBYTES + vrow * 128 + (((vch | 1) ^ vsx) * 16) + (vch & 1) * 8;
    const bf16* ksrc = Kg + (size_t)krow * ZLD + kch * 8;
    const bf16* vsrc = Vtg + (size_t)vrow * (size_t)N + vch * 8;
    u32x4 kreg = *(const GAS u32x4*)ksrc, vreg = *(const GAS u32x4*)vsrc;
    bf16x8 qr[2][4];
#pragma unroll
    for (int h = 0; h < 2; ++h)
#pragma unroll
        for (int d0 = 0; d0 < 4; ++d0) qr[h][d0] = *(const GAS bf16x8*)(Qw + (size_t)r32 * ZLD + h * 64 + d0 * 16 + hi * 8);
    LAS float* wsf = (LAS float*)(lds + WSF_OFF) + (tid >> 6) * 32;
    const LAS unsigned char* kaddr[4]; const LAS unsigned char* vaddr[4];
#pragma unroll
    for (int d0 = 0; d0 < 4; ++d0) kaddr[d0] = lds + r32 * 128 + (((2 * d0 + hi) ^ ((r32 >> 1) & 7)) * 16);
#pragma unroll
    for (int j = 0; j < 4; ++j) vaddr[j] = lds + KBYTES + r32 * 128 + (((2 * j + hi) ^ ((r32 >> 1) & 7)) * 16);
    float mhat[2] = {0.f, 0.f}, l[2] = {0.f, 0.f};
#pragma unroll
    for (int h = 0; h < 2; ++h) { o[h][0] = f32x16{}; o[h][1] = f32x16{}; }
    bf16x8 kf[4]; u32x4 vfa[2][2]; f32x16 p[2]; u32x4 pw[2][2];
#define LDK2(PAR, KB) do { _Pragma("unroll") for (int d0 = 0; d0 < 4; ++d0) kf[d0] = *(const LAS bf16x8*)(kaddr[d0] + ((PAR) * BUF + (KB) * 32 * KW * 2)); } while (0)
#define LDV2(PAR, KB) do { _Pragma("unroll") for (int dd = 0; dd < 2; ++dd) _Pragma("unroll") for (int jj = 0; jj < 2; ++jj) vfa[dd][jj] = *(const LAS u32x4*)(vaddr[2 * (KB) + jj] + ((PAR) * BUF + dd * 32 * 128)); } while (0)
#define QK2() do { _Pragma("unroll") for (int h = 0; h < 2; ++h) { const float nm_ = -mhat[h]; _Pragma("unroll") for (int r = 0; r < 16; ++r) p[h][r] = nm_; } \
        __builtin_amdgcn_s_setprio(1); _Pragma("unroll") for (int h = 0; h < 2; ++h) { \
        _Pragma("unroll") for (int d0 = 0; d0 < 4; ++d0) p[h] = __builtin_amdgcn_mfma_f32_32x32x16_bf16(kf[d0], qr[h][d0], p[h], 0, 0, 0); } __builtin_amdgcn_s_setprio(0); } while (0)
#define SM2(h, FIRST) do { \
        float rm = fmaxf(p[h][0], p[h][1]); \
        _Pragma("unroll") for (int r = 2; r < 16; ++r) rm = fmaxf(rm, p[h][r]); \
        rm = xmax32(rm); \
        const bool first = (FIRST); \
        if (first || __any(rm > THR)) { \
            const float dl = first ? rm : fmaxf(rm, 0.f); \
            mhat[h] += dl; \
            _Pragma("unroll") for (int r = 0; r < 16; ++r) p[h][r] -= dl; \
            if (!first) { \
                const float f = __builtin_amdgcn_exp2f(-dl); l[h] *= f; \
                wsf[r32] = f; \
                _Pragma("unroll") for (int r = 0; r < 16; ++r) { const float fr = wsf[crow(r, hi)]; o[h][0][r] *= fr; o[h][1][r] *= fr; } \
            } \
        } \
        _Pragma("unroll") for (int r = 0; r < 16; ++r) p[h][r] = __builtin_amdgcn_exp2f(p[h][r]); \
        { f32x2 s2 = (f32x2){p[h][0], p[h][1]}; _Pragma("unroll") for (int r = 2; r < 16; r += 2) s2 += (f32x2){p[h][r], p[h][r + 1]}; l[h] += s2.x + s2.y; } \
        _Pragma("unroll") for (int e = 0; e < 4; ++e) { pw[h][0][e] = cvtpk(p[h][2 * e], p[h][2 * e + 1]); pw[h][1][e] = cvtpk(p[h][8 + 2 * e], p[h][8 + 2 * e + 1]); } \
    } while (0)
#define PV2() do { __builtin_amdgcn_s_setprio(1); _Pragma("unroll") for (int h = 0; h < 2; ++h) _Pragma("unroll") for (int dd = 0; dd < 2; ++dd) _Pragma("unroll") for (int jj = 0; jj < 2; ++jj) \
        o[h][dd] = __builtin_amdgcn_mfma_f32_32x32x16_bf16(__builtin_bit_cast(bf16x8, pw[h][jj]), __builtin_bit_cast(bf16x8, vfa[dd][jj]), o[h][dd], 0, 0, 0); __builtin_amdgcn_s_setprio(0); } while (0)
#define TILE2(PAR, t) do { \
        *(LAS u32x4*)(kdst + (PAR) * BUF) = kreg; \
        *(LAS u32x2*)(vdst0 + (PAR) * BUF) = (u32x2){vreg.x, vreg.y}; *(LAS u32x2*)(vdst1 + (PAR) * BUF) = (u32x2){vreg.z, vreg.w}; \
        __syncthreads(); \
        if ((t) + 1 < NT) { kreg = *(const GAS u32x4*)(ksrc + (size_t)((t) + 1) * 64 * ZLD); vreg = *(const GAS u32x4*)(vsrc + ((t) + 1) * 64); } \
        LDK2(PAR, 0); QK2(); \
        __builtin_amdgcn_sched_barrier(0); \
        LDK2(PAR, 1); LDV2(PAR, 0); \
        __builtin_amdgcn_sched_barrier(0); \
        SM2(0, (t) == 0); SM2(1, (t) == 0); \
        __builtin_amdgcn_sched_barrier(0); \
        QK2(); PV2(); \
        __builtin_amdgcn_sched_barrier(0); \
        LDV2(PAR, 1); \
        __builtin_amdgcn_sched_barrier(0); \
        SM2(0, false); SM2(1, false); \
        __builtin_amdgcn_sched_barrier(0); \
        PV2(); \
        __builtin_amdgcn_sched_barrier(0); \
    } while (0)
    for (int t = 0; t < NT; t += 2) { TILE2(0, t); TILE2(1, t + 1); }
#undef TILE2
#undef PV2
#undef SM2
#undef QK2
#undef LDV2
#undef LDK2
#pragma unroll
    for (int h = 0; h < 2; ++h) {
        const float lt = xsum32(l[h]);
        wsf[r32] = 1.f / lt;
#pragma unroll
        for (int r = 0; r < 16; ++r) { const float fr = wsf[crow(r, hi)]; o[h][0][r] *= fr; o[h][1][r] *= fr; }
    }
}

constexpr int NUNITS = 192;
__device__ __forceinline__ void attn_unit_diff(int xq, int u, LAS unsigned char* lds, const bf16* Z, const bf16* VtA, bf16* OAB, const LAS float* btabs, const LAS float* lamL, const int layer, const float* subg, const int wave) {
    const int tid = my_tid(wave);
    const int lane = tid & 63, r32 = lane & 31, hi = lane >> 5;
    int N, tok0, hd, qb;
    if (u < 128) { N = NP; const int grp = xq + 8 * (u >> 6); tok0 = (grp >> 2) * NP; hd = grp & 3; qb = u & 63; }
    else         { N = NS; const int v = u - 128, grp = xq + 8 * (v >> 5); tok0 = MC_P + (grp >> 2) * NS; hd = grp & 3; qb = v & 31; }
    const int qg = wave >> 1, c = wave & 1, q0w = qb * 128 + qg * 32;
    const bf16* Qw = Z + (size_t)(tok0 + q0w) * ZLD + hd * 128 + c * 64;
    const bf16* Kg = Z + (size_t)tok0 * ZLD + 512 + hd * 128;
    const bf16* Vt = VtA + (size_t)tok0 * 512 + (size_t)(hd * 128) * N;
    f32x16 o[4];
    attn_core<128, 128, true>(lds, Qw, Kg, Vt, N, c * 64, q0w, btabs + hd * BT_N, o, wave);
    LAS float* ex = (LAS float*)(lds + 65536) + qg * 4096;
    if (c == 1) {
#pragma unroll
        for (int r = 0; r < 16; ++r)
#pragma unroll
            for (int d = 0; d < 4; ++d) ex[crow(r, hi) * 128 + d * 32 + r32] = o[d][r];
    }
    __syncthreads();
    if (c == 0) {
        const float lam = lamL[layer], lam_init = layer == 0 ? 0.2f : 0.35550934f;
        float gsc[4];
#pragma unroll
        for (int d = 0; d < 4; ++d) gsc[d] = subg[d * 32 + r32] * (1.f - lam_init);
        bf16* Ow = OAB + (size_t)(tok0 + q0w) * DM + hd * 128;
#pragma unroll
        for (int r = 0; r < 16; ++r) {
            float v[4]; float ss = 0.f;
#pragma unroll
            for (int d = 0; d < 4; ++d) { v[d] = o[d][r] - lam * ex[crow(r, hi) * 128 + d * 32 + r32]; ss += v[d] * v[d]; }
            ss = half_sum(ss, lane);
            const float rstd = 1.f / sqrtf(ss * (1.f / 128.f) + 1e-5f);
#pragma unroll
            for (int d = 0; d < 4; ++d) Ow[(size_t)crow(r, hi) * DM + d * 32 + r32] = f2bf(v[d] * rstd * gsc[d]);
        }
    }
}
__device__ __forceinline__ void attn_unit_gqa(int xq, int u, LAS unsigned char* lds, const bf16* Z, const bf16* VtB, bf16* OAB, const LAS float* btabs, const int wave) {
    const int tid = my_tid(wave);
    const int lane = tid & 63, r32 = lane & 31, hi = lane >> 5;
    int N, tok0, qb; const int hd = xq & 1;
    if (u < 64) { N = NP; tok0 = (xq >> 1) * NP; qb = u; }
    else        { N = NS; tok0 = MC_P + (xq >> 1) * NS; qb = u - 64; }
    const int hp = wave >> 2, rg = wave & 3, q0w = qb * 128 + rg * 32;
    const bf16* Qw = Z + (size_t)(tok0 + q0w) * ZLD + 1536 + hd * 256 + hp * 128;
    const bf16* Kg = Z + (size_t)tok0 * ZLD + 2048 + hd * 64;
    const bf16* Vt = VtB + (size_t)tok0 * 128 + (size_t)(hd * 64) * N;
    f32x16 o[2][2];
    attn_core_gqa2(lds, Qw, Kg, Vt, N, o, wave);
#pragma unroll
    for (int h = 0; h < 2; ++h) {
        bf16* Ow = OAB + (size_t)(tok0 + q0w) * DM + 512 + (hd * 4 + hp * 2 + h) * 64;
#pragma unroll
        for (int r = 0; r < 16; ++r)
#pragma unroll
            for (int d = 0; d < 2; ++d) Ow[(size_t)crow(r, hi) * DM + d * 32 + r32] = f2bf(o[h][d][r]);
    }
    (void)btabs;
}

#define XB_TMO      128
#define XB_XCNT(j)  (256  + 64 * (j))
#define XB_XSUB(j)  (1280 + 64 * (j))
#define XB_XGEN(j)  (2304 + 64 * (j))
#define XB_TOP      3328
#define XB_TOPGEN   3392
#define XCD_BAR_WORDS 3456
#define XB_SPIN_CAP (1u << 18)

__device__ __forceinline__ unsigned xb_ld(unsigned* p)              { return __hip_atomic_load(p, __ATOMIC_RELAXED, __HIP_MEMORY_SCOPE_AGENT); }
__device__ __forceinline__ unsigned xb_add(unsigned* p, unsigned v) { return __hip_atomic_fetch_add(p, v, __ATOMIC_RELAXED, __HIP_MEMORY_SCOPE_AGENT); }
__device__ __forceinline__ unsigned xb_xcc_id() { return (unsigned)__builtin_amdgcn_s_getreg((3 << 11) | 20) & 0xFu; }
#define XB_SPIN(cond, bar) do { unsigned _sp = 0; while (cond) { __builtin_amdgcn_s_sleep(1); \
    if ((++_sp & 255u) == 0u) { if (xb_ld(&(bar)[XB_TMO])) break; if (_sp > XB_SPIN_CAP) { atomicAdd(&(bar)[XB_TMO], 1u); break; } } } } while (0)

struct XcdBarrier {
    unsigned* bar; unsigned x;
    volatile LAS unsigned* st;
};

__device__ __forceinline__ XcdBarrier xcd_barrier_post(unsigned* bar, volatile LAS unsigned* st, bool leader) {
    XcdBarrier b; b.bar = bar; b.x = xb_xcc_id(); b.st = st;
    if (leader) (void)xb_add(&bar[XB_XCNT(b.x)], 1u);
    return b;
}
__device__ __forceinline__ void xcd_barrier_complete(unsigned* bar, unsigned x, unsigned& nloc, unsigned& nx) {
    const unsigned G = gridDim.x * gridDim.y * gridDim.z;
    unsigned sum, cnt, mine, sp = 0u;
    for (;;) {
        sum = 0u; cnt = 0u; mine = 0u;
#pragma unroll
        for (unsigned j = 0; j < 16; ++j) { const unsigned c = xb_ld(&bar[XB_XCNT(j)]); sum += c; cnt += (c > 0u) ? 1u : 0u; mine = (j == x) ? c : mine; }
        if (sum == G) break;
        __builtin_amdgcn_s_sleep(1);
        if ((++sp & 255u) == 0u) { if (xb_ld(&bar[XB_TMO])) break; if (sp > XB_SPIN_CAP) { atomicAdd(&bar[XB_TMO], 1u); break; } }
    }
    nloc = mine > 0u ? mine : 1u; nx = cnt > 0u ? cnt : 1u;
}

__device__ __forceinline__ void xcd_barrier(const XcdBarrier& b, bool leader) {
    asm volatile("s_waitcnt vmcnt(0)" ::: "memory");
    __syncthreads();
    if (leader) {
        unsigned* bar = b.bar;
        __builtin_amdgcn_s_waitcnt(0);
        unsigned nloc = b.st[0], nx = b.st[1];
        if (nloc == 0u) { xcd_barrier_complete(bar, b.x, nloc, nx); b.st[0] = nloc; b.st[1] = nx; }
        const unsigned old = xb_add(&bar[XB_XSUB(b.x)], 1u);
        const unsigned gen = old / nloc;
        if (old + 1u == (gen + 1u) * nloc) {
            __builtin_amdgcn_fence(__ATOMIC_RELEASE, "agent");
            asm volatile("s_waitcnt vmcnt(0)" ::: "memory");
            const unsigned og = xb_add(&bar[XB_TOP], 1u);
            const unsigned tg = og / nx;
            if (og + 1u == (tg + 1u) * nx) xb_add(&bar[XB_TOPGEN], 1u);
            else XB_SPIN(xb_ld(&bar[XB_TOPGEN]) == tg, bar);
            __builtin_amdgcn_fence(__ATOMIC_ACQUIRE, "agent");
            xb_add(&bar[XB_XGEN(b.x)], 1u);
            asm volatile("s_waitcnt vmcnt(0)" ::: "memory");
        } else {
            XB_SPIN(xb_ld(&bar[XB_XGEN(b.x)]) == gen, bar);
            __builtin_amdgcn_fence(__ATOMIC_ACQUIRE, "agent");
            asm volatile("s_waitcnt vmcnt(0)" ::: "memory");
        }
    }
    __syncthreads();
}

__device__ __forceinline__ unsigned long long ldptr(LAS unsigned char* lds, int k) {
    int z = 0; asm volatile("" : "+v"(z));
    const unsigned long long v = ((volatile LAS unsigned long long*)(lds + PTAB_OFF + z))[k];
    const unsigned lo = __builtin_amdgcn_readfirstlane((unsigned)v), hi = __builtin_amdgcn_readfirstlane((unsigned)(v >> 32));
    return ((unsigned long long)hi << 32) | lo;
}
__device__ __forceinline__ int t5_bucket(int rel) {
    const int ret = rel > 0 ? 16 : 0; const int n = rel < 0 ? -rel : rel;
    const float nf = (float)(n > 1 ? n : 1);
    int large = 8 + (int)(logf(nf / 8.f) / 2.772588722239781f * 8.f);
    large = large < 15 ? large : 15;
    return ret + (n < 8 ? n : large);
}

__global__ void __launch_bounds__(NTHR, 2) fwd_megakernel(Params P) {
    extern __shared__ __attribute__((aligned(16))) unsigned char lds_raw[];
    LAS unsigned char* lds = (LAS unsigned char*)lds_raw;
    cg::grid_group grid = cg::this_grid();
    int tid = threadIdx.x, lane = tid & 63; const int wave = __builtin_amdgcn_readfirstlane(tid >> 6);
    const int G = gridDim.x, bid = blockIdx.x;
    grid.sync();
    if (tid < 4) ((volatile LAS unsigned*)(lds + MISC_OFF + 32))[tid] = 0u;
    __syncthreads();
    (void)xcd_barrier_post((unsigned*)(P.ws + WS_CTL) + 12288, (volatile LAS unsigned*)(lds + MISC_OFF + 32), tid == 0);
#define GRID_SYNC() do { XcdBarrier b_; b_.bar = (unsigned*)(WSP + WS_CTL) + 12288; b_.x = xb_xcc_id(); b_.st = (volatile LAS unsigned*)(lds + MISC_OFF + 32); xcd_barrier(b_, my_tid(wave) == 0); } while (0)
    const int gw = bid * NWAVES + wave, NGW = G * NWAVES;
    if (tid < 20) ((LAS unsigned long long*)(lds + PTAB_OFF))[tid] = (unsigned long long)P.in[tid];
    if (tid == 20) ((LAS unsigned long long*)(lds + PTAB_OFF))[20] = (unsigned long long)P.out;
    if (tid == 21) ((LAS unsigned long long*)(lds + PTAB_OFF))[21] = (unsigned long long)P.ws;
    __syncthreads();
#define INP(k) ((const float*)ldptr(lds, (k)))
#define OUTP ((float*)ldptr(lds, 20))
#define WSP ((unsigned char*)ldptr(lds, 21))
    volatile LAS unsigned* slot = (volatile LAS unsigned*)(lds + MISC_OFF);
    LAS float* lamL = (LAS float*)(lds + MISC_OFF + 16);
    LAS float* btabs = (LAS float*)(lds + MISC_OFF + 64);
#define X_PROMPT INP(0)
#define X_SAMPLE INP(1)
#define WS_BF(off) ((bf16*)(WSP + (off)))

    { const float* t5 = INP(2);
      for (int i = tid; i < 4 * BT_N; i += NTHR) { const int h = i / BT_N, rel = min(max((i % BT_N) - 256, -128), 128); btabs[i] = t5[t5_bucket(rel) * 4 + h] * LOG2E; } }
    if (wave == 0) {
        const float* lq1 = INP(6); const float* lk1 = INP(7); const float* lq2 = INP(8); const float* lk2 = INP(9);
        for (int l = 0; l < 2; ++l) {
            const float s1 = wave_sum(lq1[l * 64 + lane] * lk1[l * 64 + lane], lane), s2 = wave_sum(lq2[l * 64 + lane] * lk2[l * 64 + lane], lane);
            const float lam_init = 0.8f - 0.6f * expf(-0.3f * (float)l);
            if (lane == 0) lamL[l] = expf(s1) - expf(s2) + lam_init;
        }
    }
    __syncthreads();

    {
        LAS float* scr = (LAS float*)(lds + wave * 16384);
        constexpr int I_IN = (DM / 64) * (INC / 32), I_UA = (512 / 64) * (DM / 32), I_O = (DM / 64) * (DM / 32), I_1 = (DM / 64) * (DFF / 32), I_2 = (DFF / 64) * (DM / 32);
        constexpr int PER_L = I_IN + 2 * I_UA + I_O + I_1 + I_2;
        for (int it = gw; it < 2 * PER_L; it += NGW) {
            const int l = it / PER_L; int r = it % PER_L;
            if (r < I_IN) { p0_transpose_item(INP(4) + (size_t)l * DM * INC, DM, INC, WS_BF(WS_WIN) + (size_t)l * INC * DM, scr, r, lane); continue; } r -= I_IN;
            if (r < I_UA) { p0_transpose_item(INP(13) + (size_t)l * 512 * DM, 512, DM, WS_BF(WS_WUA) + (size_t)l * DM * 512, scr, r, lane); continue; } r -= I_UA;
            if (r < I_UA) { p0_transpose_item(INP(14) + (size_t)l * 512 * DM, 512, DM, WS_BF(WS_WUB) + (size_t)l * DM * 512, scr, r, lane); continue; } r -= I_UA;
            if (r < I_O)  { p0_transpose_item(INP(15) + (size_t)l * DM * DM, DM, DM, WS_BF(WS_WO) + (size_t)l * DM * DM, scr, r, lane); continue; } r -= I_O;
            if (r < I_1)  { p0_transpose_item(INP(17) + (size_t)l * DM * DFF, DM, DFF, WS_BF(WS_W1) + (size_t)l * DFF * DM, scr, r, lane); continue; } r -= I_1;
            p0_transpose_item(INP(18) + (size_t)l * DFF * DM, DFF, DM, WS_BF(WS_W2) + (size_t)l * DM * DFF, scr, r, lane);
        }
    }

    for (int chunk = 0; chunk < 2; ++chunk) {
        const int prow0 = chunk * MC_P, srow0 = MPROMPT + chunk * 16384;
        for (int layer = 0; layer < 2; ++layer) {
            tid = my_tid(wave); lane = tid & 63;
            {
                const float* xP = layer == 0 ? X_PROMPT : OUTP;
                const float* xS = layer == 0 ? X_SAMPLE : OUTP + (size_t)MPROMPT * DM;
                const float* gn = INP(3) + layer * DM; bf16* Hb = WS_BF(WS_H);
                int m = gw;
                do {
                    const float* xr = m < MC_P ? xP + (size_t)(prow0 + m) * DM : xS + (size_t)(srow0 - MPROMPT + (m - MC_P)) * DM;
                    const int m2 = m + NGW;
                    if (m2 < MC) { const float* xr2 = m2 < MC_P ? xP + (size_t)(prow0 + m2) * DM : xS + (size_t)(srow0 - MPROMPT + (m2 - MC_P)) * DM;
                        rms_row2_to_bf16(xr, xr2, gn, Hb + (size_t)m * DM, Hb + (size_t)m2 * DM, lane); }
                    else rms_row_to_bf16(xr, gn, Hb + (size_t)m * DM, lane);
                    m += 2 * NGW;
                } while (m < MC);
            }
            GRID_SYNC();
            {
                pg8::Gemm g{WS_BF(WS_H), WS_BF(WS_WIN) + (size_t)layer * INC * DM, MC, INC, DM, DM, DM}; pg8::StaticOrder S; S.init(MC, INC, G, bid);
                pg8::EpiInProj E{WS_BF(WS_Z), WS_BF(WS_G), INP(5) + layer * GLD, C2};
                pg8::gemm_phase<pg8::EpiInProj, pg8::StaticOrder, true, true>(lds, g, S, E, wave);
            }
            GRID_SYNC();
            tid = my_tid(wave); lane = tid & 63;
            {
                bf16* Zb = WS_BF(WS_Z); bf16* VtA = WS_BF(WS_VTA); bf16* VtB = WS_BF(WS_VTB); const float* gq = INP(11) + layer * 64; const float* gk = INP(12) + layer * 64;
                for (int tile = bid; tile < MC / 64; tile += G) {
                    const int m0 = tile * 64; int tok0, N;
                    if (m0 < MC_P) { N = NP; tok0 = (m0 / NP) * NP; } else { N = NS; tok0 = MC_P + ((m0 - MC_P) / NS) * NS; }
                    prepass_tile(Zb, VtA, VtB, gq, gk, m0, tok0, N, lds, wave, lane);
                }
            }
            GRID_SYNC();
            {
                const bf16* Zb = WS_BF(WS_Z); const bf16* VtA = WS_BF(WS_VTA); bf16* OAB = WS_BF(WS_OAB); const float* sg = INP(10) + layer * 128;
                const int x0 = (int)(xb_xcc_id() & 7u);
                for (int xx = 0; xx < 8; ++xx) {
                    const int xq = (x0 + xx) & 7;
                    unsigned* ctr = (unsigned*)(WSP + WS_CTL) + (((chunk * 2 + layer) * 2) * 8 + xq) * 64;
                    for (;;) {
                        if (my_tid(wave) == 0) slot[0] = atomicAdd(ctr, 1u);
                        __syncthreads();
                        const int u = (int)slot[0];
                        if (u >= NUNITS) break;
                        attn_unit_diff(xq, u, lds, Zb, VtA, OAB, btabs, lamL, layer, sg, wave);
                    }
                    __syncthreads();
                }
            }
            {
                const bf16* Zb = WS_BF(WS_Z); const bf16* VtB = WS_BF(WS_VTB); bf16* OAB = WS_BF(WS_OAB);
                const int x0 = (int)(xb_xcc_id() & 7u);
                for (int xx = 0; xx < 8; ++xx) {
                    const int xq = (x0 + xx) & 7;
                    unsigned* ctr = (unsigned*)(WSP + WS_CTL) + (((chunk * 2 + layer) * 2 + 1) * 8 + xq) * 64;
                    for (;;) {
                        if (my_tid(wave) == 0) slot[0] = atomicAdd(ctr, 1u);
                        __syncthreads();
                        const int u = (int)slot[0];
                        if (u >= 96) break;
                        attn_unit_gqa(xq, u, lds, Zb, VtB, OAB, btabs, wave);
                    }
                    __syncthreads();
                }
            }
            GRID_SYNC();
            {
                pg8::Gemm g{WS_BF(WS_OAB), WS_BF(WS_WUA) + (size_t)layer * DM * 512, MC, DM, 512, DM, 512}; pg8::StaticOrder S; S.init(MC, DM, G, bid);
                pg8::EpiGate<false> E{WS_BF(WS_U), WS_BF(WS_G), 0};
                pg8::gemm_phase<pg8::EpiGate<false>, pg8::StaticOrder, true, true>(lds, g, S, E, wave);
            }
            {
                pg8::Gemm g{WS_BF(WS_OAB) + 512, WS_BF(WS_WUB) + (size_t)layer * DM * 512, MC, DM, 512, DM, 512}; pg8::StaticOrder S; S.init(MC, DM, G, bid);
                pg8::EpiGate<true> E{WS_BF(WS_U), WS_BF(WS_G), 1024};
                pg8::gemm_phase<pg8::EpiGate<true>, pg8::StaticOrder, true, true>(lds, g, S, E, wave);
            }
            GRID_SYNC();
            {
                const float* xP = layer == 0 ? X_PROMPT : OUTP;
                const float* xS = layer == 0 ? X_SAMPLE : OUTP + (size_t)MPROMPT * DM;
                pg8::Gemm g{WS_BF(WS_U), WS_BF(WS_WO) + (size_t)layer * DM * DM, MC, DM, DM, DM, DM}; pg8::StaticOrder S; S.init(MC, DM, G, bid);
                pg8::EpiResid E{xP, xS, OUTP, prow0, srow0};
                pg8::gemm_phase<pg8::EpiResid, pg8::StaticOrder, true, true>(lds, g, S, E, wave);
            }
            GRID_SYNC();
            tid = my_tid(wave); lane = tid & 63;
            {
                const float* xo = OUTP; const float* gn = INP(16) + layer * DM; bf16* Hb = WS_BF(WS_H);
                int m = gw;
                do {
                    const int grow = m < MC_P ? prow0 + m : srow0 + (m - MC_P);
                    const int m2 = m + NGW;
                    if (m2 < MC) { const int grow2 = m2 < MC_P ? prow0 + m2 : srow0 + (m2 - MC_P);
                        rms_row2_to_bf16(xo + (size_t)grow * DM, xo + (size_t)grow2 * DM, gn, Hb + (size_t)m * DM, Hb + (size_t)m2 * DM, lane); }
                    else rms_row_to_bf16(xo + (size_t)grow * DM, gn, Hb + (size_t)m * DM, lane);
                    m += 2 * NGW;
                } while (m < MC);
            }
            GRID_SYNC();
            {
                pg8::Gemm g{WS_BF(WS_H), WS_BF(WS_W1) + (size_t)layer * DFF * DM, MC, DFF, DM, DM, DM}; pg8::StaticOrder S; S.init(MC, DFF, G, bid);
                pg8::EpiRelu2 E{WS_BF(WS_ACT)};
                pg8::gemm_phase<pg8::EpiRelu2, pg8::StaticOrder, true, true>(lds, g, S, E, wave);
            }
            GRID_SYNC();
            {
                float* xo = OUTP;
                pg8::Gemm g{WS_BF(WS_ACT), WS_BF(WS_W2) + (size_t)layer * DM * DFF, MC, DM, DFF, DFF, DFF}; pg8::StaticOrder S; S.init(MC, DM, G, bid);
                pg8::EpiResid E{xo, xo + (size_t)MPROMPT * DM, xo, prow0, srow0};
                pg8::gemm_phase<pg8::EpiResid, pg8::StaticOrder, true, true>(lds, g, S, E, wave);
            }
            GRID_SYNC();
        }
    }
    tid = my_tid(wave); lane = tid & 63;
    { float* xo = OUTP; const float* gn = INP(19);
      int m = gw; do { rms_row_f32_inplace(xo + (size_t)m * DM, gn, lane); m += NGW; } while (m < MTOT); }
}

extern "C" void kernel_launch(void* const* d_in, const int* in_sizes, int n_in, void* d_out, int out_size, void* d_ws, size_t ws_size, hipStream_t stream) {
    static int grid = 0;
    if (grid == 0) {
        if (n_in != 20 || out_size != MTOT * DM || ws_size < WS_END) { fprintf(stderr, "kernel_launch: unexpected problem shape (n_in %d out %d ws %zu)\n", n_in, out_size, ws_size); grid = -1; return; }
        int dev = 0, cus = 0, per_cu = 0;
        hipGetDevice(&dev);
        hipDeviceGetAttribute(&cus, hipDeviceAttributeMultiprocessorCount, dev);
        hipFuncSetAttribute((const void*)fwd_megakernel, hipFuncAttributeMaxDynamicSharedMemorySize, LDS_BYTES);
        hipOccupancyMaxActiveBlocksPerMultiprocessor(&per_cu, (const void*)fwd_megakernel, NTHR, LDS_BYTES);
        if (per_cu < 1) per_cu = 1;
        grid = cus * per_cu;
        (void)hipGetLastError();
    }
    if (grid < 0) return;
    if (hipMemsetAsync((char*)d_ws + WS_CTL, 0, 65536, stream) != hipSuccess) { fprintf(stderr, "kernel_launch: memset failed\n"); return; }
    Params p{};
    for (int i = 0; i < 20; ++i) p.in[i] = (const float*)d_in[i];
    p.out = (float*)d_out; p.ws = (unsigned char*)d_ws;
    void* args[] = {&p};
    hipError_t e = hipLaunchCooperativeKernel((const void*)fwd_megakernel, dim3(grid), dim3(NTHR), args, LDS_BYTES, stream);
    if (e != hipSuccess) fprintf(stderr, "cooperative launch failed: %s (grid %d)\n", hipGetErrorString(e), grid);
}
```
